# Optimizing an MI355X kernel written in HIP

```python
import math
import jax, jax.numpy as jnp
from jax import lax
import numpy as np

D_MODEL = 2048
BATCH = 2
SEQ = 8192
DEPTH = 1

MIX_WIDTH = D_MODEL
CONV_WIDTH = D_MODEL // 2
CONV_K = 3
ATTN_WIDTH = MIX_WIDTH - CONV_WIDTH
DIFF_HEAD_DIM = 64
N_DIFF_HEADS = ATTN_WIDTH // (2 * DIFF_HEAD_DIM)
DIFF_V_DIM = 2 * DIFF_HEAD_DIM
Q_BLOCK = 128
ROPE_THETA = 10000.0
NORM_EPS = 1e-6
SUBLN_EPS = 1e-5
N_KEYS = 128
N_EXPERTS = N_KEYS * N_KEYS
PEER_HEADS = 8
PEER_KEY_DIM = 256
PEER_HALF = PEER_KEY_DIM // 2
PEER_TOPK = 16
PEER_BLOCK = 128
N_ADA = 6
IN_COLS = 3 * CONV_WIDTH + 3 * ATTN_WIDTH

kernel_name = "hymba_shortconv_diffattn_peer_adaln"


def rms_norm(x, g, eps=NORM_EPS):
    xf = x.astype(jnp.float32)
    y = xf * lax.rsqrt(jnp.mean(xf * xf, axis=-1, keepdims=True) + eps)
    return (y * g.astype(jnp.float32)).astype(x.dtype)


def modulate(h, shift, scale):
    return h * (1.0 + scale[:, None, :]) + shift[:, None, :]


def rope_tables(positions, dim):
    inv_freq = ROPE_THETA ** (-jnp.arange(0, dim, 2, dtype=jnp.float32) / dim)
    ang = positions.astype(jnp.float32)[..., None] * inv_freq
    ang = jnp.concatenate([ang, ang], axis=-1)
    return jnp.cos(ang)[:, :, None, None, :], jnp.sin(ang)[:, :, None, None, :]


def apply_rope(x, cos, sin):
    half = x.shape[-1] // 2
    x1, x2 = x[..., :half], x[..., half:]
    rot = jnp.concatenate([-x2, x1], axis=-1)
    return x.astype(jnp.float32) * cos + rot.astype(jnp.float32) * sin


def causal_short_conv(z, w):
    S = z.shape[1]
    zp = jnp.pad(z, ((0, 0), (CONV_K - 1, 0), (0, 0)))
    return sum(w[j] * lax.dynamic_slice_in_dim(zp, j, S, axis=1) for j in range(CONV_K))


def diff_attention(hq, hk, hv, positions, q_norm_g, k_norm_g, lam, subln_g, lam_init):
    B, S, _ = hq.shape
    H, Dh, E = N_DIFF_HEADS, DIFF_HEAD_DIM, DIFF_V_DIM
    q = rms_norm(hq.reshape(B, S, H, 2, Dh), q_norm_g)
    k = rms_norm(hk.reshape(B, S, H, 2, Dh), k_norm_g)
    cos, sin = rope_tables(positions, Dh)
    q32 = apply_rope(q, cos, sin) * (Dh ** -0.5)
    k32 = apply_rope(k, cos, sin)
    v32 = hv.reshape(B, S, H, E).astype(jnp.float32)
    kpos = jnp.arange(S)
    n_blocks = S // Q_BLOCK

    def block(i):
        qb = lax.dynamic_slice_in_dim(q32, i * Q_BLOCK, Q_BLOCK, axis=1)
        s = jnp.einsum('bqhmd,bkhmd->bhmqk', qb, k32)
        qpos = i * Q_BLOCK + jnp.arange(Q_BLOCK)
        mask = kpos[None, :] <= qpos[:, None]
        p = jax.nn.softmax(jnp.where(mask, s, -jnp.inf), axis=-1)
        a = p[:, :, 0] - lam * p[:, :, 1]
        return jnp.einsum('bhqk,bkhe->bqhe', a, v32)

    o = lax.map(block, jnp.arange(n_blocks))
    o = jnp.moveaxis(o, 0, 1).reshape(B, S, H, E)
    o = rms_norm(o, subln_g, SUBLN_EPS) * (1.0 - lam_init)
    return o.reshape(B, S, H * E).astype(hq.dtype)


def peer_ffn(h, w_q, keys1, keys2, expert_u, expert_v):
    B, S, D = h.shape
    T = B * S
    hf = h.reshape(T, D)
    q = (hf @ w_q).reshape(T, PEER_HEADS, 2, PEER_HALF)
    s1 = jnp.einsum('thd,nd->thn', q[:, :, 0], keys1)
    s2 = jnp.einsum('thd,nd->thn', q[:, :, 1], keys2)
    v1, i1 = lax.top_k(s1, PEER_TOPK)
    v2, i2 = lax.top_k(s2, PEER_TOPK)
    cand = (v1[..., :, None] + v2[..., None, :]).reshape(T, PEER_HEADS, PEER_TOPK * PEER_TOPK)
    cand_idx = (i1[..., :, None] * N_KEYS + i2[..., None, :]).reshape(T, PEER_HEADS, PEER_TOPK * PEER_TOPK)
    top_s, top_p = lax.top_k(cand, PEER_TOPK)
    idx = jnp.take_along_axis(cand_idx, top_p, axis=-1)
    g = jax.nn.softmax(top_s.astype(jnp.float32), axis=-1)

    def apply(args):
        xb, ib, gb = args
        u = jnp.take(expert_u, ib, axis=0)
        a = jnp.einsum('thkd,td->thk', u, xb)
        w = (jax.nn.gelu(a.astype(jnp.float32), approximate=False) * gb).astype(xb.dtype)
        vv = jnp.take(expert_v, ib, axis=0)
        return jnp.einsum('thk,thkd->td', w, vv)

    nb = T // PEER_BLOCK
    out = lax.map(apply, (hf.reshape(nb, PEER_BLOCK, D),
                          idx.reshape(nb, PEER_BLOCK, PEER_HEADS, PEER_TOPK),
                          g.reshape(nb, PEER_BLOCK, PEER_HEADS, PEER_TOPK)))
    return out.reshape(B, S, D)


def setup_inputs(seed: int = 0) -> dict:
    key = jax.random.key(seed)
    ks = jax.random.split(key, 24)
    f32 = jnp.float32
    nrm = lambda k, shape, std: jax.random.normal(k, shape, f32) * std
    gain = lambda k, shape: 1.0 + 0.02 * jax.random.normal(k, shape, f32)
    L, D = DEPTH, D_MODEL
    return {
        "x": nrm(ks[0], (BATCH, SEQ, D), 1.0),
        "c": nrm(ks[1], (BATCH, D), 1.0),
        "positions": jnp.broadcast_to(jnp.arange(SEQ, dtype=jnp.int32), (BATCH, SEQ)),
        "w_ada": nrm(ks[2], (L, D, N_ADA * D), D ** -0.5),
        "b_ada": nrm(ks[3], (L, N_ADA * D), 0.02),
        "norm1_g": gain(ks[4], (L, D)),
        "w_in": nrm(ks[5], (L, D, IN_COLS), D ** -0.5),
        "conv_w": nrm(ks[6], (L, CONV_K, CONV_WIDTH), CONV_K ** -0.5),
        "q_norm_g": gain(ks[7], (L, DIFF_HEAD_DIM)),
        "k_norm_g": gain(ks[8], (L, DIFF_HEAD_DIM)),
        "lambda_q1": nrm(ks[9], (L, DIFF_HEAD_DIM), 0.1),
        "lambda_k1": nrm(ks[10], (L, DIFF_HEAD_DIM), 0.1),
        "lambda_q2": nrm(ks[11], (L, DIFF_HEAD_DIM), 0.1),
        "lambda_k2": nrm(ks[12], (L, DIFF_HEAD_DIM), 0.1),
        "subln_g": gain(ks[13], (L, DIFF_V_DIM)),
        "w_out": nrm(ks[14], (L, MIX_WIDTH, D), MIX_WIDTH ** -0.5),
        "norm2_g": gain(ks[15], (L, D)),
        "w_peer_q": nrm(ks[16], (L, D, PEER_HEADS * PEER_KEY_DIM), D ** -0.5),
        "sub_keys1": nrm(ks[17], (L, N_KEYS, PEER_HALF), PEER_HALF ** -0.5),
        "sub_keys2": nrm(ks[18], (L, N_KEYS, PEER_HALF), PEER_HALF ** -0.5),
        "expert_u": nrm(ks[19], (L, N_EXPERTS, D), D ** -0.5),
        "expert_v": nrm(ks[20], (L, N_EXPERTS, D), PEER_HEADS ** -0.5),
    }


def reference(x, c, positions, w_ada, b_ada, norm1_g, w_in, conv_w, q_norm_g, k_norm_g,
              lambda_q1, lambda_k1, lambda_q2, lambda_k2, subln_g, w_out, norm2_g,
              w_peer_q, sub_keys1, sub_keys2, expert_u, expert_v):
    split_at = [CONV_WIDTH, 2 * CONV_WIDTH, 3 * CONV_WIDTH,
                3 * CONV_WIDTH + ATTN_WIDTH, 3 * CONV_WIDTH + 2 * ATTN_WIDTH]
    for l in range(DEPTH):
        lam_init = 0.8 - 0.6 * math.exp(-0.3 * l)
        mod = jax.nn.silu(c) @ w_ada[l] + b_ada[l]
        shift1, scale1, gate1, shift2, scale2, gate2 = jnp.split(mod, N_ADA, axis=-1)

        h = modulate(rms_norm(x, norm1_g[l]), shift1, scale1)
        proj = h @ w_in[l]
        cb, cc, ch, aq, ak, av = jnp.split(proj, split_at, axis=-1)
        y_conv = cb * causal_short_conv(cc * ch, conv_w[l])
        lam = (jnp.exp(jnp.sum(lambda_q1[l].astype(jnp.float32) * lambda_k1[l].astype(jnp.float32)))
               - jnp.exp(jnp.sum(lambda_q2[l].astype(jnp.float32) * lambda_k2[l].astype(jnp.float32)))
               + lam_init)
        y_attn = diff_attention(aq, ak, av, positions, q_norm_g[l], k_norm_g[l],
                                lam, subln_g[l], lam_init)
        mix = jnp.concatenate([y_conv, y_attn], axis=-1) @ w_out[l]
        x = x + gate1[:, None, :] * mix

        h2 = modulate(rms_norm(x, norm2_g[l]), shift2, scale2)
        ffn = peer_ffn(h2, w_peer_q[l], sub_keys1[l], sub_keys2[l], expert_u[l], expert_v[l])
        x = x + gate2[:, None, :] * ffn
    return x
```

```cpp
#include <hip/hip_runtime.h>
#include <hip/hip_cooperative_groups.h>
#include <cstdio>
#include <cstdint>
namespace cg = cooperative_groups;

#define DI __device__ __forceinline__
typedef unsigned short bf16_t;
typedef short bf16x8 __attribute__((ext_vector_type(8)));
typedef short s16x4 __attribute__((ext_vector_type(4)));
typedef float f32x16 __attribute__((ext_vector_type(16)));
typedef float f32x4 __attribute__((ext_vector_type(4)));
typedef float f32x2 __attribute__((ext_vector_type(2)));
typedef unsigned u32x4 __attribute__((ext_vector_type(4)));
typedef unsigned u32x2 __attribute__((ext_vector_type(2)));
typedef __bf16 bf2_t __attribute__((ext_vector_type(2)));

constexpr int DM = 2048, NB = 2, SEQ = 8192, NT = NB * SEQ;
constexpr int INC = 6144, NADA = 12288;
constexpr int NTHREADS = 512, NWAVES = 8;
constexpr int LDS_BYTES = 147456;

struct Params {
  const float* x; const float* c; const int* pos; const float* w_ada; const float* b_ada; const float* g1;
  const float* w_in; const float* conv_w; const float* qg; const float* kg; const float* lq1; const float* lk1;
  const float* lq2; const float* lk2; const float* subg; const float* w_out; const float* g2; const float* w_pq;
  const float* keys1; const float* keys2; const float* eu; const float* ev;
  float* out;
  unsigned* ctrl; float* mod; float* ropec; float* ropes;
  bf16_t* WinT; bf16_t* WoutT; bf16_t* WqkT; unsigned char* EU; unsigned char* EV; bf16_t* hbuf;
  float* su; float* sv;
  bf16_t* BCH; bf16_t* Qb; bf16_t* Kb; bf16_t* Vt; bf16_t* mixA;
  float* scores; int* tidx; float* tg;
  bf16_t* x1b;
};

DI unsigned pk_bf16(float lo, float hi) {
  f32x2 v = {lo, hi};
  bf2_t b = __builtin_convertvector(v, bf2_t);
  return __builtin_bit_cast(unsigned, b);
}
DI float bf_lo(unsigned u) { return __uint_as_float(u << 16); }
DI float bf_hi(unsigned u) { return __uint_as_float(u & 0xffff0000u); }
DI int crow(int i, int h) { return (i & 3) + 8 * (i >> 2) + 4 * h; }
DI int my_tid() { int t = threadIdx.x; asm volatile("" : "+v"(t)); return t; }
#define MFMA32(a, b, c) __builtin_amdgcn_mfma_f32_32x32x16_bf16((a), (b), (c), 0, 0, 0)

DI void ada_item(const Params& p, int item, float* lds) {
  const int tid = my_tid(), cgp = tid & 7, kl = tid >> 3;
  const int col = item * 32 + cgp * 4;
  f32x4 a0 = {0.f, 0.f, 0.f, 0.f}, a1 = {0.f, 0.f, 0.f, 0.f};
  for (int k = kl; k < DM; k += NTHREADS / 8) {
    const f32x4 w = *(const f32x4*)(p.w_ada + (size_t)k * NADA + col);
    const float c0 = p.c[k], c1 = p.c[DM + k];
    const float s0 = c0 / (1.f + __expf(-c0)), s1 = c1 / (1.f + __expf(-c1));
    a0 += w * s0; a1 += w * s1;
  }
  float* dst = lds + (kl * 8 + cgp) * 8;
  *(f32x4*)dst = a0; *(f32x4*)(dst + 4) = a1;
  __syncthreads();
  if (tid < 64) {
    const int b = tid >> 5, j = tid & 31, cg2 = j >> 2, e = j & 3;
    float s = 0.f;
    for (int q = 0; q < NTHREADS / 8; ++q) s += lds[(q * 8 + cg2) * 8 + b * 4 + e];
    p.mod[b * NADA + item * 32 + j] = s + p.b_ada[item * 32 + j];
  }
  __syncthreads();
}

DI void transpose_item(const float* __restrict__ W, bf16_t* __restrict__ Wt, int K, int N, int item2, float* lds0) {
  const int tfull = my_tid();
  const int tid = tfull & 255, item = item2 * 2 + (tfull >> 8);
  float* lds = lds0 + (tfull >> 8) * (64 * 65);
  const int ntn = N / 64;
  const int k0 = (item / ntn) * 64, n0 = (item % ntn) * 64;
  {
    const int r = tid >> 4, c4 = (tid & 15) * 4;
#pragma unroll
    for (int rr = 0; rr < 4; ++rr) {
      const int row = r + rr * 16;
      const f32x4 v = *(const f32x4*)(W + (size_t)(k0 + row) * N + n0 + c4);
      float* d = lds + row * 65 + c4;
      d[0] = v[0]; d[1] = v[1]; d[2] = v[2]; d[3] = v[3];
    }
  }
  __syncthreads();
  {
    const int n = tid >> 2, kq = (tid & 3) * 16;
    u32x4 o0, o1;
    float t[16];
#pragma unroll
    for (int j = 0; j < 16; ++j) t[j] = lds[(kq + j) * 65 + n];
    o0[0] = pk_bf16(t[0], t[1]); o0[1] = pk_bf16(t[2], t[3]); o0[2] = pk_bf16(t[4], t[5]); o0[3] = pk_bf16(t[6], t[7]);
    o1[0] = pk_bf16(t[8], t[9]); o1[1] = pk_bf16(t[10], t[11]); o1[2] = pk_bf16(t[12], t[13]); o1[3] = pk_bf16(t[14], t[15]);
    bf16_t* d = Wt + (size_t)(n0 + n) * K + k0 + kq;
    *(u32x4*)d = o0; *(u32x4*)(d + 8) = o1;
  }
  __syncthreads();
}

DI bf16x8 cvt8(const float* src) {
  const f32x4 a = *(const f32x4*)src, b = *(const f32x4*)(src + 4);
  u32x4 o; o[0] = pk_bf16(a[0], a[1]); o[1] = pk_bf16(a[2], a[3]); o[2] = pk_bf16(b[0], b[1]); o[3] = pk_bf16(b[2], b[3]);
  return __builtin_bit_cast(bf16x8, o);
}
DI void wqk_phase(const Params& p) {
  const int tid = my_tid();
  const int lane = tid & 63, r = lane & 31, h = lane >> 5;
  const int gw = __builtin_amdgcn_readfirstlane(blockIdx.x * NWAVES + (tid >> 6)), nw = gridDim.x * NWAVES;
  for (int it = gw; it < 2048; it += nw) {
    const int hh = it >> 7, mt = it & 3, kq = (it & 127) >> 2;
    const float* keys = ((hh & 1) ? p.keys2 : p.keys1) + (size_t)(mt * 32 + r) * 128 + h * 8;
    bf16x8 af[8];
#pragma unroll
    for (int ks = 0; ks < 8; ++ks) af[ks] = cvt8(keys + ks * 16);
#pragma unroll
    for (int nt = 0; nt < 2; ++nt) {
      const int krow = kq * 64 + nt * 32 + r;
      const float* wq = p.w_pq + (size_t)krow * DM + hh * 128 + h * 8;
      f32x16 acc;
#pragma unroll
      for (int i = 0; i < 16; ++i) acc[i] = 0.f;
#pragma unroll
      for (int ks = 0; ks < 8; ++ks) acc = MFMA32(af[ks], cvt8(wq + ks * 16), acc);
      bf16_t* dst = p.WqkT + (size_t)(hh * 128 + mt * 32) * DM + krow;
#pragma unroll
      for (int i = 0; i < 16; ++i) dst[(size_t)crow(i, h) * DM] = (bf16_t)(pk_bf16(acc[i], 0.f) & 0xffffu);
    }
  }
}

template <bool SRC_BF16>
DI void norm_mod_phase(const void* __restrict__ srcv, const float* __restrict__ g, const float* __restrict__ mod,
                       int which_shift, bf16_t* __restrict__ dst) {
  const int tid = my_tid();
  const int lane = tid & 63;
  const int gw = __builtin_amdgcn_readfirstlane(blockIdx.x * NWAVES + (tid >> 6)), nw = gridDim.x * NWAVES;
  f32x4 ga[8], sh[8];
  int cur_b = -1;
  for (int tok = gw; tok < NT; tok += nw) {
    const int b = tok >> 13;
    if (b != cur_b) {
      cur_b = b;
      const float* mb = mod + b * NADA + which_shift * DM;
#pragma unroll
      for (int j = 0; j < 8; ++j) {
        const int col = (j * 64 + lane) * 4;
        const f32x4 gg = *(const f32x4*)(g + col);
        const f32x4 sc = *(const f32x4*)(mb + DM + col);
        sh[j] = *(const f32x4*)(mb + col);
#pragma unroll
        for (int e = 0; e < 4; ++e) ga[j][e] = gg[e] * (1.f + sc[e]);
      }
    }
    f32x4 v[8];
    float ss = 0.f;
#pragma unroll
    for (int j = 0; j < 8; ++j) {
      if (SRC_BF16) {
        const u32x2 w = *(const u32x2*)((const bf16_t*)srcv + (size_t)tok * DM + (j * 64 + lane) * 4);
        v[j][0] = bf_lo(w[0]); v[j][1] = bf_hi(w[0]); v[j][2] = bf_lo(w[1]); v[j][3] = bf_hi(w[1]);
      } else {
        v[j] = *(const f32x4*)((const float*)srcv + (size_t)tok * DM + (j * 64 + lane) * 4);
      }
      ss += v[j][0] * v[j][0] + v[j][1] * v[j][1] + v[j][2] * v[j][2] + v[j][3] * v[j][3];
    }
#pragma unroll
    for (int m = 1; m < 64; m <<= 1) ss += __shfl_xor(ss, m);
    const float inv = rsqrtf(ss * (1.f / DM) + 1e-6f);
#pragma unroll
    for (int j = 0; j < 8; ++j) {
      const int col = (j * 64 + lane) * 4;
      f32x4 y;
#pragma unroll
      for (int e = 0; e < 4; ++e) y[e] = (v[j][e] * inv) * ga[j][e] + sh[j][e];
      u32x2 o; o[0] = pk_bf16(y[0], y[1]); o[1] = pk_bf16(y[2], y[3]);
      *(u32x2*)(dst + (size_t)tok * DM + col) = o;
    }
  }
}

DI unsigned fmap(float f) { const unsigned u = __float_as_uint(f); return u ^ ((u >> 31) ? 0xffffffffu : 0x80000000u); }
DI float funmap(unsigned u) { return __uint_as_float(u ^ ((u >> 31) ? 0x80000000u : 0xffffffffu)); }
#define INSERT16(list, key) { unsigned _k = (key); _Pragma("unroll") for (int _j = 0; _j < 16; ++_j) { const unsigned _hi = max(list[_j], _k); _k = min(list[_j], _k); list[_j] = _hi; } }

template <bool DESC>
DI void bitonic_sort16(unsigned (&a)[16]) {
#pragma unroll
  for (int k = 2; k <= 16; k <<= 1) {
#pragma unroll
    for (int j = k >> 1; j > 0; j >>= 1) {
#pragma unroll
      for (int i = 0; i < 16; ++i) {
        const int l = i ^ j;
        if (l > i) {
          const bool up = (((i & k) == 0) == DESC);
          const unsigned hi = max(a[i], a[l]), lo = min(a[i], a[l]);
          a[i] = up ? hi : lo; a[l] = up ? lo : hi;
        }
      }
    }
  }
}
DI void merge_top16(unsigned (&L)[16], const unsigned (&G)[16]) {
#pragma unroll
  for (int i = 0; i < 16; ++i) L[i] = max(L[i], G[i]);
#pragma unroll
  for (int j = 8; j > 0; j >>= 1) {
#pragma unroll
    for (int i = 0; i < 16; ++i) {
      const int l = i ^ j;
      if (l > i) { const unsigned hi = max(L[i], L[l]), lo = min(L[i], L[l]); L[i] = hi; L[l] = lo; }
    }
  }
}

constexpr int CAND_I[64] = {0, 0, 0, 0, 0, 0, 0, 0, 0, 0, 0, 0, 0, 0, 0, 0, 1, 1, 1, 1, 1, 1, 1, 1, 2, 2, 2, 2, 2, 3, 3, 3, 3, 4, 4, 4, 5, 5, 6, 6, 7, 7, 8, 9, 10, 11, 12, 13, 14, 15, 0, 0, 0, 0, 0, 0, 0, 0, 0, 0, 0, 0, 0, 0};
constexpr int CAND_J[64] = {0, 1, 2, 3, 4, 5, 6, 7, 8, 9, 10, 11, 12, 13, 14, 15, 0, 1, 2, 3, 4, 5, 6, 7, 0, 1, 2, 3, 4, 0, 1, 2, 3, 0, 1, 2, 0, 1, 0, 1, 0, 1, 0, 0, 0, 0, 0, 0, 0, 0, 0, 0, 0, 0, 0, 0, 0, 0, 0, 0, 0, 0, 0, 0};

DI void topk_merge4(const u32x4* pl, unsigned (&list)[16]) {
#pragma unroll
  for (int q = 0; q < 4; ++q) { const u32x4 v = pl[q]; list[4 * q] = v[0]; list[4 * q + 1] = v[1]; list[4 * q + 2] = v[2]; list[4 * q + 3] = v[3]; }
#pragma unroll
  for (int part = 1; part < 4; ++part) {
    unsigned g[16];
#pragma unroll
    for (int q = 0; q < 4; ++q) { const u32x4 v = pl[part * 4 + q]; g[15 - 4 * q] = v[0]; g[14 - 4 * q] = v[1]; g[13 - 4 * q] = v[2]; g[12 - 4 * q] = v[3]; }
    merge_top16(list, g);
  }
}
DI void topk_finish(const Params& p, unsigned (&list)[16], int tok, int hh, unsigned* my) {
  {
    unsigned other[16];
#pragma unroll
    for (int j = 0; j < 16; ++j) other[j] = (unsigned)__shfl_xor((int)list[j], 1);
    const bool first = (hh & 1) == 0;
    unsigned A[16], B[16];
#pragma unroll
    for (int j = 0; j < 16; ++j) { A[j] = first ? list[j] : other[j]; B[j] = first ? other[j] : list[j]; }
#pragma unroll
    for (int w = 0; w < 4; ++w) {
      my[w] = (A[4 * w] & 127u) | ((A[4 * w + 1] & 127u) << 8) | ((A[4 * w + 2] & 127u) << 16) | ((A[4 * w + 3] & 127u) << 24);
      my[4 + w] = (B[4 * w] & 127u) | ((B[4 * w + 1] & 127u) << 8) | ((B[4 * w + 2] & 127u) << 16) | ((B[4 * w + 3] & 127u) << 24);
    }
    float va[16], vb[16];
#pragma unroll
    for (int j = 0; j < 16; ++j) { va[j] = funmap(A[j] & ~127u); vb[j] = funmap(B[j] & ~127u); }
    unsigned top[16];
#pragma unroll
    for (int grp = 0; grp < 4; ++grp) {
      unsigned g[16];
#pragma unroll
      for (int t = 0; t < 16; ++t) {
        const int c = grp * 16 + t;
        g[t] = (c < 50) ? ((fmap(va[CAND_I[c]] + vb[CAND_J[c]]) & ~255u) | (unsigned)(CAND_I[c] * 16 + CAND_J[c])) : 0u;
      }
      if (grp == 0) {
        bitonic_sort16<true>(g);
#pragma unroll
        for (int j = 0; j < 16; ++j) top[j] = g[j];
      } else {
        bitonic_sort16<false>(g);
        merge_top16(top, g);
      }
    }
    float ev[16], sum = 0.f;
    const float mx = funmap(top[0] & ~255u);
#pragma unroll
    for (int j = 0; j < 16; ++j) { ev[j] = __expf(funmap(top[j] & ~255u) - mx); sum += ev[j]; }
    const float rs = 1.f / sum;
    const int head = hh >> 1;
    if (first) {
      int* dst = p.tidx + ((size_t)tok * 8 + head) * 16;
#pragma unroll
      for (int j = 0; j < 16; ++j) {
        const unsigned code = top[j] & 255u, ci = code >> 4, cj = code & 15u;
        const unsigned i1 = (my[ci >> 2] >> ((ci & 3u) * 8)) & 255u;
        const unsigned i2 = (my[4 + (cj >> 2)] >> ((cj & 3u) * 8)) & 255u;
        dst[j] = (int)(i1 * 128u + i2);
      }
    } else {
      float* dst = p.tg + ((size_t)tok * 8 + head) * 16;
#pragma unroll
      for (int j = 0; j < 16; ++j) dst[j] = ev[j] * rs;
    }
  }
}

template <int EPI>
DI void gemm_epilogue(const Params& p, const f32x16 (&acc)[4][2], int m_base, int tn, int wc, int r, int h) {
  const int n_base = tn * 128 + wc * 64;
  if (EPI == 1) {
    const int grp = tn >> 3;
    if (grp < 3) {
#pragma unroll
      for (int mt = 0; mt < 4; ++mt) {
        const int m = m_base + mt * 32 + r;
#pragma unroll
        for (int nt = 0; nt < 2; ++nt)
#pragma unroll
          for (int g = 0; g < 4; ++g) {
            const int n = n_base + nt * 32 + 8 * g + 4 * h;
            u32x2 o; o[0] = pk_bf16(acc[mt][nt][4 * g], acc[mt][nt][4 * g + 1]); o[1] = pk_bf16(acc[mt][nt][4 * g + 2], acc[mt][nt][4 * g + 3]);
            *(u32x2*)(p.BCH + (size_t)m * 3072 + n) = o;
          }
      }
    } else if (grp == 5) {
      const int head = tn - 40;
#pragma unroll
      for (int mt = 0; mt < 4; ++mt) {
        const int m = m_base + mt * 32 + r;
        const int b = m >> 13, s = m & 8191;
#pragma unroll
        for (int nt = 0; nt < 2; ++nt)
#pragma unroll
          for (int i = 0; i < 16; ++i) {
            const int e = wc * 64 + nt * 32 + crow(i, h);
            p.Vt[((size_t)(((b * 8 + head) * 128 + (s >> 6)) * 128 + e)) * 64 + (s & 63)] = (bf16_t)(pk_bf16(acc[mt][nt][i], 0.f) & 0xffffu);
          }
      }
    } else {
      const bool isq = (grp == 3);
      const int head = tn - (isq ? 24 : 32);
      const int half = wc;
      const float* gn = isq ? p.qg : p.kg;
      const float osc = isq ? (0.125f * 1.4426950408889634f) : 1.f;
      bf16_t* dbase = isq ? p.Qb : p.Kb;
#pragma unroll
      for (int mt = 0; mt < 4; ++mt) {
        const int m = m_base + mt * 32 + r;
        const int b = m >> 13, s = m & 8191;
        float ss = 0.f;
#pragma unroll
        for (int nt = 0; nt < 2; ++nt)
#pragma unroll
          for (int i = 0; i < 16; ++i) ss += acc[mt][nt][i] * acc[mt][nt][i];
        ss += __shfl_xor(ss, 32);
        const float inv = rsqrtf(ss * (1.f / 64.f) + 1e-6f);
        bf16_t* dst = dbase + ((size_t)(((b * 8 + head) * 2 + half)) * SEQ + s) * 64;
#pragma unroll
        for (int g = 0; g < 4; ++g) {
          const int d0 = 8 * g + 4 * h;
          const f32x4 cs = *(const f32x4*)(p.ropec + (size_t)m * 32 + d0);
          const f32x4 sn = *(const f32x4*)(p.ropes + (size_t)m * 32 + d0);
          const f32x4 ga = *(const f32x4*)(gn + d0);
          const f32x4 gb = *(const f32x4*)(gn + 32 + d0);
          float o0[4], o1[4];
#pragma unroll
          for (int j = 0; j < 4; ++j) {
            const float y0 = acc[mt][0][4 * g + j] * inv * ga[j];
            const float y1 = acc[mt][1][4 * g + j] * inv * gb[j];
            o0[j] = (y0 * cs[j] - y1 * sn[j]) * osc;
            o1[j] = (y1 * cs[j] + y0 * sn[j]) * osc;
          }
          u32x2 a; a[0] = pk_bf16(o0[0], o0[1]); a[1] = pk_bf16(o0[2], o0[3]);
          u32x2 bq; bq[0] = pk_bf16(o1[0], o1[1]); bq[1] = pk_bf16(o1[2], o1[3]);
          *(u32x2*)(dst + d0) = a;
          *(u32x2*)(dst + 32 + d0) = bq;
        }
      }
    }
  } else if (EPI == 2) {
#pragma unroll
    for (int mt = 0; mt < 4; ++mt) {
      const int m = m_base + mt * 32 + r;
      const int b = m >> 13;
      const float* gate = p.mod + b * NADA + 2 * DM;
#pragma unroll
      for (int nt = 0; nt < 2; ++nt)
#pragma unroll
        for (int g = 0; g < 4; ++g) {
          const int n = n_base + nt * 32 + 8 * g + 4 * h;
          const f32x4 xv = *(const f32x4*)(p.x + (size_t)m * DM + n);
          const f32x4 gt = *(const f32x4*)(gate + n);
          f32x4 o;
#pragma unroll
          for (int j = 0; j < 4; ++j) o[j] = xv[j] + gt[j] * acc[mt][nt][4 * g + j];
          u32x2 ob; ob[0] = pk_bf16(o[0], o[1]); ob[1] = pk_bf16(o[2], o[3]);
          *(u32x2*)(p.x1b + (size_t)m * DM + n) = ob;
        }
    }
  } else {
    unsigned* plist = (unsigned*)p.scores;
#pragma unroll
    for (int mt = 0; mt < 4; ++mt) {
      const int m = m_base + mt * 32 + r;
      unsigned a[16], b[16];
#pragma unroll
      for (int i = 0; i < 16; ++i) {
        a[i] = (fmap(acc[mt][0][i]) & ~127u) | (unsigned)(wc * 64 + crow(i, h));
        b[i] = (fmap(acc[mt][1][i]) & ~127u) | (unsigned)(wc * 64 + 32 + crow(i, h));
      }
      bitonic_sort16<true>(a);
      bitonic_sort16<false>(b);
      merge_top16(a, b);
      unsigned* dst = plist + (((size_t)m * 16 + tn) * 4 + (wc * 2 + h)) * 16;
#pragma unroll
      for (int q = 0; q < 4; ++q) { u32x4 o; o[0] = a[4 * q]; o[1] = a[4 * q + 1]; o[2] = a[4 * q + 2]; o[3] = a[4 * q + 3]; *(u32x4*)(dst + 4 * q) = o; }
    }
  }
}

template <int EPI>
DI void gemm_phase(const Params& p, const bf16_t* __restrict__ A, const bf16_t* __restrict__ Bt, int N, char* lds) {
  constexpr int K = DM;
  const int tid = my_tid(), lane = tid & 63, wave = tid >> 6, wr = wave >> 2, wc = wave & 3;
  const int r = lane & 31, h = lane >> 5;
  const int nNt = N / 256;
  const int stM = (NT / 256) / 8, stN = nNt / 4, nST = stM * stN;
  const int G = gridDim.x;
  const int xcd = blockIdx.x & 7, local = blockIdx.x >> 3;
  const int nb = (G - xcd + 7) >> 3;
  const int cnt = (nST - xcd + 7) >> 3;
  const int srow = tid >> 3, sc = tid & 7;
  for (int e = local; e < cnt * 32; e += nb) {
    const int st = xcd + 8 * (e >> 5), w = e & 31;
    const int stm = st % stM, stn = st / stM;
    const int tm = stm * 8 + (w & 7), tn = stn * 4 + (w >> 3);
    f32x16 acc[4][2];
#pragma unroll
    for (int a = 0; a < 4; ++a)
#pragma unroll
      for (int b = 0; b < 2; ++b)
#pragma unroll
        for (int i = 0; i < 16; ++i) acc[a][b][i] = 0.f;
    const bf16_t* Ag = A + (size_t)(tm * 256 + srow) * K + ((sc ^ ((srow >> 1) & 7)) * 8);
    const bf16_t* Bg = Bt + (size_t)(tn * 256 + srow) * K + ((sc ^ ((srow >> 1) & 7)) * 8);
#define GLDS(BUF, KT) _Pragma("unroll") for (int i = 0; i < 4; ++i) { \
      __builtin_amdgcn_global_load_lds((const unsigned*)(Ag + (size_t)i * 64 * K + (KT) * 64), (unsigned*)(lds + (BUF) * 65536 + tid * 16 + i * 8192), 16, 0, 0); \
      __builtin_amdgcn_global_load_lds((const unsigned*)(Bg + (size_t)i * 64 * K + (KT) * 64), (unsigned*)(lds + (BUF) * 65536 + 32768 + tid * 16 + i * 8192), 16, 0, 0); }
    GLDS(0, 0)
    __syncthreads();
#pragma unroll 1
    for (int kt = 0; kt < K / 64; ++kt) {
      const int cur = kt & 1;
      if (kt + 1 < K / 64) { GLDS(cur ^ 1, kt + 1) }
      const char* sA = lds + cur * 65536;
      const char* sB = sA + 32768;
#pragma unroll
      for (int ks = 0; ks < 4; ++ks) {
        const int coff = ((ks * 2 + h) ^ ((r >> 1) & 7)) << 4;
        bf16x8 af[4], bfr[2];
#pragma unroll
        for (int mt = 0; mt < 4; ++mt) af[mt] = *(const bf16x8*)(sA + (wr * 128 + mt * 32 + r) * 128 + coff);
#pragma unroll
        for (int nt = 0; nt < 2; ++nt) bfr[nt] = *(const bf16x8*)(sB + (wc * 64 + nt * 32 + r) * 128 + coff);
#pragma unroll
        for (int mt = 0; mt < 4; ++mt)
#pragma unroll
          for (int nt = 0; nt < 2; ++nt) acc[mt][nt] = MFMA32(bfr[nt], af[mt], acc[mt][nt]);
      }
      __syncthreads();
    }
#undef GLDS
    if (EPI != 3) {
      gemm_epilogue<EPI>(p, acc, tm * 256 + wr * 128, tn * 2 + (wc >> 1), wc & 1, r, h);
    } else {
#pragma unroll
      for (int mt = 0; mt < 4; ++mt) {
        const int row = wr * 128 + mt * 32 + r;
        unsigned a[16], b[16];
#pragma unroll
        for (int i = 0; i < 16; ++i) {
          a[i] = (fmap(acc[mt][0][i]) & ~127u) | (unsigned)((wc & 1) * 64 + crow(i, h));
          b[i] = (fmap(acc[mt][1][i]) & ~127u) | (unsigned)((wc & 1) * 64 + 32 + crow(i, h));
        }
        bitonic_sort16<true>(a);
        bitonic_sort16<false>(b);
        merge_top16(a, b);
        unsigned* dst = (unsigned*)lds + (((row * 2 + (wc >> 1)) * 4 + ((wc & 1) * 2 + h)) * 16);
#pragma unroll
        for (int q = 0; q < 4; ++q) { u32x4 o; o[0] = a[4 * q]; o[1] = a[4 * q + 1]; o[2] = a[4 * q + 2]; o[3] = a[4 * q + 3]; *(u32x4*)(dst + 4 * q) = o; }
      }
      __syncthreads();
      {
        unsigned list[16];
        topk_merge4((const u32x4*)((const unsigned*)lds + tid * 64), list);
        topk_finish(p, list, tm * 256 + (tid >> 1), tn * 2 + (tid & 1), (unsigned*)(lds + 131072) + tid * 8);
      }
      __syncthreads();
    }
  }
}

typedef float v16f_t __attribute__((ext_vector_type(16)));
typedef float v32f_t __attribute__((ext_vector_type(32)));
typedef _Float16 v32h_t __attribute__((ext_vector_type(32)));
typedef unsigned v6u_t __attribute__((ext_vector_type(6)));
constexpr unsigned EROW = 1536u;
DI void fp6_rows_phase(const Params& p) {
  const int tid = my_tid();
  const int lane = tid & 63;
  const int gw = __builtin_amdgcn_readfirstlane(blockIdx.x * NWAVES + (tid >> 6)), nw = gridDim.x * NWAVES;
  for (int row = gw; row < 32768; row += nw) {
    const bool second = row >= 16384;
    const int r = row & 16383;
    const float* src = (second ? p.ev : p.eu) + (size_t)r * DM;
    f32x4 v[8];
    float mx = 0.f;
#pragma unroll
    for (int j = 0; j < 8; ++j) {
      v[j] = *(const f32x4*)(src + (unsigned)((j * 64 + lane) * 4));
      mx = fmaxf(mx, fmaxf(fmaxf(fabsf(v[j][0]), fabsf(v[j][1])), fmaxf(fabsf(v[j][2]), fabsf(v[j][3]))));
    }
#pragma unroll
    for (int m = 1; m < 64; m <<= 1) mx = fmaxf(mx, __shfl_xor(mx, m));
    const float sc = mx > 0.f ? 7.0f / mx : 1.f;
    const float inv = mx > 0.f ? mx * (1.f / 7.0f) : 1.f;
    v32h_t a;
#pragma unroll
    for (int j = 0; j < 8; ++j)
#pragma unroll
      for (int e = 0; e < 4; ++e) a[j * 4 + e] = (_Float16)(v[j][e] * sc);
    const v6u_t pk = __builtin_amdgcn_cvt_scalef32_pk32_fp6_f16(a, 1.0f);
    unsigned char* dst = (second ? p.EV : p.EU) + (size_t)r * EROW;
    u32x4 w0; w0[0] = pk[0]; w0[1] = pk[1]; w0[2] = pk[2]; w0[3] = pk[3];
    u32x2 w1; w1[0] = pk[4]; w1[1] = pk[5];
    *(u32x4*)(dst + (unsigned)lane * 16u) = w0;
    *(u32x2*)(dst + 1024u + (unsigned)lane * 8u) = w1;
    if (lane == 0) (second ? p.sv : p.su)[r] = inv;
  }
}

DI void conv_phase(const Params& p) {
  const int tid = my_tid();
  const int ch = (tid & 127) * 8, tsub = tid >> 7;
  float w0[8], w1[8], w2[8];
#pragma unroll
  for (int j = 0; j < 8; ++j) { w0[j] = p.conv_w[ch + j]; w1[j] = p.conv_w[1024 + ch + j]; w2[j] = p.conv_w[2048 + ch + j]; }
  for (int unit = blockIdx.x; unit < NT / 64; unit += gridDim.x) {
    const int t0 = unit * 64 + tsub * 16;
    float z1[8], z2[8];
#pragma unroll
    for (int j = 0; j < 8; ++j) { z1[j] = 0.f; z2[j] = 0.f; }
    const int s0 = t0 & 8191;
    for (int back = 2; back >= 1; --back) {
      if (s0 - back >= 0) {
        const bf16_t* rowp = p.BCH + (size_t)(t0 - back) * 3072;
        const u32x4 cv = *(const u32x4*)(rowp + 1024 + ch);
        const u32x4 hv = *(const u32x4*)(rowp + 2048 + ch);
#pragma unroll
        for (int q = 0; q < 4; ++q) {
          const float a = bf_lo(cv[q]) * bf_lo(hv[q]), b = bf_hi(cv[q]) * bf_hi(hv[q]);
          if (back == 2) { z2[2 * q] = a; z2[2 * q + 1] = b; } else { z1[2 * q] = a; z1[2 * q + 1] = b; }
        }
      }
    }
    for (int tt = 0; tt < 16; ++tt) {
      const int t = t0 + tt;
      const bf16_t* rowp = p.BCH + (size_t)t * 3072;
      const u32x4 bv = *(const u32x4*)(rowp + ch);
      const u32x4 cv = *(const u32x4*)(rowp + 1024 + ch);
      const u32x4 hv = *(const u32x4*)(rowp + 2048 + ch);
      float z0[8], y[8];
#pragma unroll
      for (int q = 0; q < 4; ++q) {
        z0[2 * q] = bf_lo(cv[q]) * bf_lo(hv[q]); z0[2 * q + 1] = bf_hi(cv[q]) * bf_hi(hv[q]);
      }
#pragma unroll
      for (int q = 0; q < 4; ++q) {
        y[2 * q] = bf_lo(bv[q]) * (w0[2 * q] * z2[2 * q] + w1[2 * q] * z1[2 * q] + w2[2 * q] * z0[2 * q]);
        y[2 * q + 1] = bf_hi(bv[q]) * (w0[2 * q + 1] * z2[2 * q + 1] + w1[2 * q + 1] * z1[2 * q + 1] + w2[2 * q + 1] * z0[2 * q + 1]);
      }
      u32x4 o;
#pragma unroll
      for (int q = 0; q < 4; ++q) o[q] = pk_bf16(y[2 * q], y[2 * q + 1]);
      *(u32x4*)(p.mixA + (size_t)t * DM + ch) = o;
#pragma unroll
      for (int j = 0; j < 8; ++j) { z2[j] = z1[j]; z1[j] = z0[j]; }
    }
  }
}

DI void deferred_prep(const Params& p, char* lds) {
  conv_phase(p);
  __syncthreads();
  for (int it = blockIdx.x; it < (DM / 64) * (DM / 64) / 2; it += gridDim.x) transpose_item(p.w_out, p.WoutT, DM, DM, it, (float*)lds);
  wqk_phase(p);
  fp6_rows_phase(p);
}

DI void attn_phase(const Params& p, char* lds, int* s_item, float* s_lam) {
  const int tid = my_tid(), lane = tid & 63, wave = tid >> 6;
  const int r = lane & 31, h = lane >> 5;
  float d1 = 0.f, d2 = 0.f, mq = 0.f, mk = 0.f;
  for (int i = 0; i < 64; ++i) {
    d1 += p.lq1[i] * p.lk1[i]; d2 += p.lq2[i] * p.lk2[i];
    mq = fmaxf(mq, fabsf(p.qg[i])); mk = fmaxf(mk, fabsf(p.kg[i]));
  }
  const float lam_init = 0.2f;
  const float negM2 = -(8.f * mq * mk * 1.4426950408889634f * 1.02f + 0.25f);
  if (tid == 0) s_lam[0] = __expf(d1) - __expf(d2) + lam_init;
  char* Qs = lds;
  char* Ks = lds + 73728;
  char* Vs = lds + 92160;
  int n_items = 0;
  bool did_conv = false;
  while (true) {
    if (tid == 0) *s_item = (int)atomicAdd(&p.ctrl[1], 1u);
    __syncthreads();
    const int item = __builtin_amdgcn_readfirstlane(*s_item);
    __syncthreads();
    if (item >= 512) break;
    ++n_items;
    const int qi = 31 - (item >> 4), bh = item & 15;
    const int q0 = qi * 256;
    unsigned thr = (unsigned)((tid >> 3) * 128 + (tid & 7) * 16);
    asm volatile("" : "+v"(thr));
    const char* Qg = (const char*)p.Qb + (size_t)(bh * 2) * SEQ * 128;
    const char* Kg = (const char*)p.Kb + (size_t)(bh * 2) * SEQ * 128;
    const char* Vg = (const char*)p.Vt + (size_t)bh * 128 * SEQ * 2;
    {
      int t2 = tid; asm volatile("" : "+v"(t2));
      char* qst = Qs + (t2 >> 3) * 144 + (t2 & 7) * 16;
#pragma unroll
      for (int i = 0; i < 8; ++i) {
        const u32x4 v = *(const u32x4*)(Qg + ((size_t)(i >> 2) * SEQ + q0 + (i & 3) * 64) * 128 + thr);
        *(u32x4*)(qst + (i >> 2) * 36864 + (i & 3) * 64 * 144) = v;
      }
    }
    const int nkt = 4 * qi + 4;
    u32x4 rk[2], rv[2];
    auto prefetch = [&](int kt) {
      const char* kb = Kg + (size_t)kt * 64 * 128;
      const char* vb = Vg + (size_t)kt * 16384;
#pragma unroll
      for (int i = 0; i < 2; ++i) {
        rk[i] = *(const u32x4*)(kb + ((size_t)i * SEQ) * 128 + thr);
        rv[i] = *(const u32x4*)(vb + i * 64 * 128 + thr);
      }
    };
    prefetch(0);
    f32x16 O0[4], O1[4];
#pragma unroll
    for (int et = 0; et < 4; ++et)
#pragma unroll
      for (int i = 0; i < 16; ++i) { O0[et][i] = 0.f; O1[et][i] = 0.f; }
    float l0 = 0.f, l1 = 0.f;
    const int qglob = q0 + wave * 32 + r;
    char* kst = Ks + (tid >> 3) * 144 + (tid & 7) * 16;
    char* vst = Vs + (tid >> 3) * 144 + ((tid & 7) >> 1) * 32 + (tid & 1) * 8;
    const char* kfr0 = Ks + r * 144 + h * 16;
    const char* qfr = Qs + (wave * 32 + r) * 144 + h * 16;
    const char* vfr0 = Vs + r * 144 + h * 16;
#define KV_STORE(BUF) _Pragma("unroll") for (int i = 0; i < 2; ++i) { \
        *(u32x4*)(kst + (BUF) * 36864 + i * 9216) = rk[i]; \
        u32x2 lo, hi; lo[0] = rv[i][0]; lo[1] = rv[i][1]; hi[0] = rv[i][2]; hi[1] = rv[i][3]; \
        *(u32x2*)(vst + (BUF) * 36864 + i * 64 * 144) = lo; \
        *(u32x2*)(vst + (BUF) * 36864 + i * 64 * 144 + 16) = hi; }
    KV_STORE(0)
    if (nkt > 1) prefetch(1);
    __syncthreads();
#pragma unroll 1
    for (int kt = 0; kt < nkt; ++kt) {
      const int cur = kt & 1;
      const char* kfr = kfr0 + cur * 36864;
      const char* vfr = vfr0 + cur * 36864;
      const int key0 = kt * 64;
      const bool diag = (kt >= 4 * qi);
#pragma unroll
      for (int kk = 0; kk < 2; ++kk) {
        const int kbase = key0 + kk * 32;
        if (kbase > q0 + wave * 32 + 31) continue;
        bf16x8 P0[2], P1[2];
        bf16x8 vf[4];
#pragma unroll
        for (int hf = 0; hf < 2; ++hf) {
          bf16x8 kf[4], qf[4];
#pragma unroll
          for (int ks = 0; ks < 4; ++ks) {
            kf[ks] = *(const bf16x8*)(kfr + hf * 9216 + kk * 32 * 144 + ks * 32);
            qf[ks] = *(const bf16x8*)(qfr + hf * 36864 + ks * 32);
          }
          __builtin_amdgcn_sched_barrier(0);
          f32x16 X;
#pragma unroll
          for (int i = 0; i < 16; ++i) X[i] = negM2;
#pragma unroll
          for (int ks = 0; ks < 4; ++ks) X = MFMA32(kf[ks], qf[ks], X);
          if (hf == 1) {
#pragma unroll
            for (int et = 0; et < 2; ++et)
#pragma unroll
              for (int s = 0; s < 2; ++s) vf[et * 2 + s] = *(const bf16x8*)(vfr + et * 32 * 144 + (kk * 2 + s) * 32);
          }
          __builtin_amdgcn_sched_barrier(0);
          float ls = 0.f;
#pragma unroll
          for (int i = 0; i < 16; ++i) {
            float e0 = __builtin_amdgcn_exp2f(X[i]);
            if (diag) e0 = ((kbase + crow(i, h)) <= qglob) ? e0 : 0.f;
            X[i] = e0; ls += e0;
          }
#pragma unroll
          for (int s = 0; s < 2; ++s) {
            u32x4 a;
#pragma unroll
            for (int j = 0; j < 4; ++j) a[j] = pk_bf16(X[8 * s + 2 * j], X[8 * s + 2 * j + 1]);
            if (hf == 0) P0[s] = __builtin_bit_cast(bf16x8, a); else P1[s] = __builtin_bit_cast(bf16x8, a);
          }
          if (hf == 0) l0 += ls; else l1 += ls;
          __builtin_amdgcn_sched_barrier(0);
        }
        bf16x8 vg[4];
#pragma unroll
        for (int et = 2; et < 4; ++et)
#pragma unroll
          for (int s = 0; s < 2; ++s) vg[(et - 2) * 2 + s] = *(const bf16x8*)(vfr + et * 32 * 144 + (kk * 2 + s) * 32);
        __builtin_amdgcn_sched_barrier(0);
#pragma unroll
        for (int et = 0; et < 2; ++et) {
#pragma unroll
          for (int s = 0; s < 2; ++s) {
            O0[et] = MFMA32(vf[et * 2 + s], P0[s], O0[et]);
            O1[et] = MFMA32(vf[et * 2 + s], P1[s], O1[et]);
          }
        }
        __builtin_amdgcn_sched_barrier(0);
#pragma unroll
        for (int et = 2; et < 4; ++et) {
#pragma unroll
          for (int s = 0; s < 2; ++s) {
            O0[et] = MFMA32(vg[(et - 2) * 2 + s], P0[s], O0[et]);
            O1[et] = MFMA32(vg[(et - 2) * 2 + s], P1[s], O1[et]);
          }
        }
        __builtin_amdgcn_sched_barrier(0);
      }
      if (kt + 1 < nkt) {
        if (cur == 0) { KV_STORE(1) } else { KV_STORE(0) }
        if (kt + 2 < nkt) prefetch(kt + 2);
      }
      __syncthreads();
    }
#undef KV_STORE
    l0 += __shfl_xor(l0, 32); l1 += __shfl_xor(l1, 32);
    const float i0 = 1.f / l0, i1 = s_lam[0] / l1;
    float ss = 0.f;
#pragma unroll
    for (int et = 0; et < 4; ++et)
#pragma unroll
      for (int i = 0; i < 16; ++i) { const float o = O0[et][i] * i0 - O1[et][i] * i1; O0[et][i] = o; ss += o * o; }
    ss += __shfl_xor(ss, 32);
    const float rinv = rsqrtf(ss * (1.f / 128.f) + 1e-5f) * (1.f - lam_init);
    const int t = (bh >> 3) * SEQ + qglob;
    bf16_t* dst = p.mixA + (size_t)t * DM + 1024 + (bh & 7) * 128;
#pragma unroll
    for (int et = 0; et < 4; ++et)
#pragma unroll
      for (int g = 0; g < 4; ++g) {
        const int e = et * 32 + 8 * g + 4 * h;
        const f32x4 sg = *(const f32x4*)(p.subg + e);
        u32x2 o;
        o[0] = pk_bf16(O0[et][4 * g] * rinv * sg[0], O0[et][4 * g + 1] * rinv * sg[1]);
        o[1] = pk_bf16(O0[et][4 * g + 2] * rinv * sg[2], O0[et][4 * g + 3] * rinv * sg[3]);
        *(u32x2*)(dst + e) = o;
      }
    if (!did_conv) { did_conv = true; deferred_prep(p, lds); }
  }
  if (!did_conv) deferred_prep(p, lds);
}

constexpr int bitrev4(int j) { return ((j & 1) << 3) | ((j & 2) << 1) | ((j & 4) >> 1) | ((j & 8) >> 3); }
DI void expert_phase(const Params& p) {
  const int tid = my_tid();
  const int lane = tid & 63;
  const int gw = __builtin_amdgcn_readfirstlane(blockIdx.x * NWAVES + (tid >> 6)), nw = gridDim.x * NWAVES;
  const int b0 = lane & 1, b1 = (lane >> 1) & 1, b2 = (lane >> 2) & 1, b3 = (lane >> 3) & 1;
  const int mypick = b0 * 8 + b1 * 4 + b2 * 2 + b3;
  const unsigned loff16 = (unsigned)lane * 16u, loff8 = 1024u + (unsigned)lane * 8u;
  for (int tok = gw; tok < NT; tok += nw) {
    unsigned ln = (unsigned)lane;
    asm volatile("" : "+v"(ln));
    f32x2 hf[16];
#pragma unroll
    for (int j = 0; j < 8; ++j) {
      const u32x2 w = *(const u32x2*)((const char*)(p.hbuf + (size_t)tok * DM) + (ln * 8u + (unsigned)(j * 512)));
      f32x2 t0 = {bf_lo(w[0]), bf_hi(w[0])}, t1 = {bf_lo(w[1]), bf_hi(w[1])};
      hf[2 * j] = t0; hf[2 * j + 1] = t1;
    }
    const int* tip = p.tidx + (size_t)tok * 128;
    const float* tgp = p.tg + (size_t)tok * 128;
    const int il = tip[ln], ih = tip[64u + ln];
    const float gl = tgp[ln], gh = tgp[64u + ln];
    f32x2 out[16];
#pragma unroll
    for (int k = 0; k < 16; ++k) { f32x2 z = {0.f, 0.f}; out[k] = z; }
#pragma unroll 1
    for (int head = 0; head < 8; ++head) {
      const int isel = head < 4 ? il : ih;
      const float gsel = head < 4 ? gl : gh;
      const int lbase = (head & 3) * 16;
      const int emy = __shfl(isel, lbase + mypick);
      const float suv = p.su[emy], svv = p.sv[emy];
      float part[16];
#pragma unroll
      for (int j = 0; j < 16; ++j) {
        const int e = __builtin_amdgcn_readlane(isel, lbase + j);
        const char* urow = (const char*)p.EU + (size_t)(unsigned)e * EROW;
        const u32x4 w0 = *(const u32x4*)(urow + loff16);
        const u32x2 w1 = *(const u32x2*)(urow + loff8);
        v6u_t pk; pk[0] = w0[0]; pk[1] = w0[1]; pk[2] = w0[2]; pk[3] = w0[3]; pk[4] = w1[0]; pk[5] = w1[1];
        const v32f_t u = __builtin_amdgcn_cvt_scalef32_pk32_f32_fp6(pk, 1.0f);
        f32x2 acc = {0.f, 0.f};
#pragma unroll
        for (int q = 0; q < 16; ++q) { f32x2 t = {u[2 * q], u[2 * q + 1]}; acc = t * hf[q] + acc; }
        part[j] = acc.x + acc.y;
        if ((j & 3) == 3) __builtin_amdgcn_sched_barrier(0);
      }
#pragma unroll
      for (int j = 0; j < 8; ++j) {
        const float send = b0 ? part[j] : part[j + 8];
        const float keep = b0 ? part[j + 8] : part[j];
        part[j] = keep + __shfl_xor(send, 1);
      }
#pragma unroll
      for (int j = 0; j < 4; ++j) {
        const float send = b1 ? part[j] : part[j + 4];
        const float keep = b1 ? part[j + 4] : part[j];
        part[j] = keep + __shfl_xor(send, 2);
      }
#pragma unroll
      for (int j = 0; j < 2; ++j) {
        const float send = b2 ? part[j] : part[j + 2];
        const float keep = b2 ? part[j + 2] : part[j];
        part[j] = keep + __shfl_xor(send, 4);
      }
      {
        const float send = b3 ? part[0] : part[1];
        const float keep = b3 ? part[1] : part[0];
        part[0] = keep + __shfl_xor(send, 8);
      }
      float a = part[0];
      a += __shfl_xor(a, 16);
      a += __shfl_xor(a, 32);
      a *= suv;
      const float gm = __shfl(gsel, lbase + mypick);
      const float wgt = 0.5f * a * (1.f + erff(a * 0.70710678118654752f)) * gm * svv;
#pragma unroll
      for (int j = 0; j < 16; ++j) {
        const int e = __builtin_amdgcn_readlane(isel, lbase + j);
        const float wj = __uint_as_float((unsigned)__builtin_amdgcn_readlane((int)__float_as_uint(wgt), bitrev4(j)));
        const f32x2 wj2 = {wj, wj};
        const char* vrow = (const char*)p.EV + (size_t)(unsigned)e * EROW;
        const u32x4 w0 = *(const u32x4*)(vrow + loff16);
        const u32x2 w1 = *(const u32x2*)(vrow + loff8);
        v6u_t pk; pk[0] = w0[0]; pk[1] = w0[1]; pk[2] = w0[2]; pk[3] = w0[3]; pk[4] = w1[0]; pk[5] = w1[1];
        const v32f_t v = __builtin_amdgcn_cvt_scalef32_pk32_f32_fp6(pk, 1.0f);
#pragma unroll
        for (int q = 0; q < 16; ++q) { f32x2 t = {v[2 * q], v[2 * q + 1]}; out[q] = wj2 * t + out[q]; }
        if ((j & 3) == 3) __builtin_amdgcn_sched_barrier(0);
      }
    }
    const float* gate = p.mod + (tok >> 13) * NADA + 5 * DM;
    unsigned ln2 = (unsigned)lane;
    asm volatile("" : "+v"(ln2));
    float* orow = p.out + (size_t)tok * DM;
#pragma unroll
    for (int j = 0; j < 8; ++j) {
      const unsigned col = (unsigned)(j * 256) + ln2 * 4u;
      const u32x2 xw = *(const u32x2*)(p.x1b + (size_t)tok * DM + col);
      f32x4 xv; xv[0] = bf_lo(xw[0]); xv[1] = bf_hi(xw[0]); xv[2] = bf_lo(xw[1]); xv[3] = bf_hi(xw[1]);
      const f32x4 gt = *(const f32x4*)(gate + col);
      f32x4 o;
      o[0] = xv[0] + gt[0] * out[2 * j].x;
      o[1] = xv[1] + gt[1] * out[2 * j].y;
      o[2] = xv[2] + gt[2] * out[2 * j + 1].x;
      o[3] = xv[3] + gt[3] * out[2 * j + 1].y;
      *(f32x4*)(orow + col) = o;
    }
  }
}


DI void grid_barrier(unsigned* ctrl, unsigned k) {
  __syncthreads();
  if (my_tid() == 0) {
    __threadfence();
    unsigned bid = blockIdx.x, G = gridDim.x;
    asm volatile("" : "+s"(bid), "+s"(G));
    const unsigned g = bid & 7;
    const unsigned nbg = (G - g + 7) >> 3;
    const unsigned prev = __hip_atomic_fetch_add(&ctrl[64 + g * 64], 1u, __ATOMIC_RELAXED, __HIP_MEMORY_SCOPE_AGENT);
    if (prev + 1 == nbg * (k + 1)) {
      const unsigned p2 = __hip_atomic_fetch_add(&ctrl[640], 1u, __ATOMIC_RELAXED, __HIP_MEMORY_SCOPE_AGENT);
      if (p2 + 1 == 8u * (k + 1)) __hip_atomic_store(&ctrl[704], k + 1, __ATOMIC_RELAXED, __HIP_MEMORY_SCOPE_AGENT);
    }
    while (__hip_atomic_load(&ctrl[704], __ATOMIC_RELAXED, __HIP_MEMORY_SCOPE_AGENT) < k + 1) __builtin_amdgcn_s_sleep(2);
    __threadfence();
  }
  __syncthreads();
}

typedef const Params __attribute__((address_space(4)))* KParams;
#define FRESH_PARAMS(q) asm volatile("" : "+s"(kp)); Params q; __builtin_memcpy(&q, kp, sizeof(Params));

__global__ void __launch_bounds__(NTHREADS, 2) fwd_megakernel(Params p_unused) {
  cg::grid_group grid = cg::this_grid();
  extern __shared__ __attribute__((aligned(16))) char lds[];
  __shared__ int s_item;
  __shared__ float s_lam;
  const int tid = my_tid();
  const int G = gridDim.x;
  KParams kp = (KParams)__builtin_amdgcn_kernarg_segment_ptr();
  if (gridDim.y == 0x7fffu) grid.sync();
  {
    FRESH_PARAMS(p)
    for (int it = blockIdx.x; it < 384; it += G) ada_item(p, it, (float*)lds);
    for (int it = blockIdx.x; it < (DM / 64) * (INC / 64) / 2; it += G) transpose_item(p.w_in, p.WinT, DM, INC, it, (float*)lds);
    for (int i = blockIdx.x * NTHREADS + tid; i < NT * 32; i += G * NTHREADS) {
      const int t = i >> 5, f = i & 31;
      const float inv_freq = powf(10000.f, -(float)(2 * f) / 64.f);
      const float ang = (float)p.pos[t] * inv_freq;
      float s, c;
      sincosf(ang, &s, &c);
      p.ropec[i] = c; p.ropes[i] = s;
    }
  }
  { FRESH_PARAMS(pb) grid_barrier(pb.ctrl, 0u); }
  { FRESH_PARAMS(p) norm_mod_phase<false>(p.x, p.g1, p.mod, 0, p.hbuf); }
  { FRESH_PARAMS(pb) grid_barrier(pb.ctrl, 1u); }
  { FRESH_PARAMS(p) gemm_phase<1>(p, p.hbuf, p.WinT, INC, lds); }
  { FRESH_PARAMS(pb) grid_barrier(pb.ctrl, 2u); }
  { FRESH_PARAMS(p) attn_phase(p, lds, &s_item, &s_lam); }
  { FRESH_PARAMS(pb) grid_barrier(pb.ctrl, 3u); }
  { FRESH_PARAMS(p) gemm_phase<2>(p, p.mixA, p.WoutT, DM, lds); }
  { FRESH_PARAMS(pb) grid_barrier(pb.ctrl, 4u); }
  { FRESH_PARAMS(p) norm_mod_phase<true>(p.x1b, p.g2, p.mod, 3, p.hbuf); }
  { FRESH_PARAMS(pb) grid_barrier(pb.ctrl, 5u); }
  { FRESH_PARAMS(p) gemm_phase<3>(p, p.hbuf, p.WqkT, DM, lds); }
  { FRESH_PARAMS(pb) grid_barrier(pb.ctrl, 6u); }
  { FRESH_PARAMS(p) expert_phase(p); }
}

extern "C" void kernel_launch(void* const* d_in, const int* in_sizes, int n_in, void* d_out, int out_size, void* d_ws,
                              size_t ws_size, hipStream_t stream) {
  static int grid_blocks = 0;
  if (!grid_blocks) {
    int dev = 0, cus = 0, per_cu = 0;
    (void)hipGetDevice(&dev);
    (void)hipDeviceGetAttribute(&cus, hipDeviceAttributeMultiprocessorCount, dev);
    (void)hipFuncSetAttribute((const void*)fwd_megakernel, hipFuncAttributeMaxDynamicSharedMemorySize, LDS_BYTES);
    (void)hipOccupancyMaxActiveBlocksPerMultiprocessor(&per_cu, fwd_megakernel, NTHREADS, LDS_BYTES);
    per_cu = 1;
    grid_blocks = cus * per_cu;
  }
  Params p{};
  p.x = (const float*)d_in[0]; p.c = (const float*)d_in[1]; p.pos = (const int*)d_in[2]; p.w_ada = (const float*)d_in[3];
  p.b_ada = (const float*)d_in[4]; p.g1 = (const float*)d_in[5]; p.w_in = (const float*)d_in[6]; p.conv_w = (const float*)d_in[7];
  p.qg = (const float*)d_in[8]; p.kg = (const float*)d_in[9]; p.lq1 = (const float*)d_in[10]; p.lk1 = (const float*)d_in[11];
  p.lq2 = (const float*)d_in[12]; p.lk2 = (const float*)d_in[13]; p.subg = (const float*)d_in[14]; p.w_out = (const float*)d_in[15];
  p.g2 = (const float*)d_in[16]; p.w_pq = (const float*)d_in[17]; p.keys1 = (const float*)d_in[18]; p.keys2 = (const float*)d_in[19];
  p.eu = (const float*)d_in[20]; p.ev = (const float*)d_in[21];
  p.out = (float*)d_out;
  char* w = (char*)d_ws;
  size_t off = 0;
  auto take = [&](size_t bytes) { char* r = w + off; off += (bytes + 255) & ~(size_t)255; return r; };
  p.ctrl = (unsigned*)take(4096);
  p.mod = (float*)take((size_t)NB * NADA * 4);
  p.ropec = (float*)take((size_t)NT * 32 * 4);
  p.ropes = (float*)take((size_t)NT * 32 * 4);
  p.WinT = (bf16_t*)take((size_t)INC * DM * 2);
  p.WoutT = (bf16_t*)take((size_t)DM * DM * 2);
  p.WqkT = (bf16_t*)take((size_t)DM * DM * 2);
  p.EU = (unsigned char*)take((size_t)16384 * DM);
  p.EV = (unsigned char*)take((size_t)16384 * DM);
  p.su = (float*)take(16384 * 4);
  p.sv = (float*)take(16384 * 4);
  p.hbuf = (bf16_t*)take((size_t)NT * DM * 2);
  p.mixA = (bf16_t*)take((size_t)NT * DM * 2);
  p.tidx = (int*)take((size_t)NT * 128 * 4);
  p.tg = (float*)take((size_t)NT * 128 * 4);
  char* region = take((size_t)NT * 3072 * 2 + 3 * (size_t)NT * 1024 * 2);
  p.BCH = (bf16_t*)region;
  p.Qb = (bf16_t*)(region + (size_t)NT * 3072 * 2);
  p.Kb = p.Qb + (size_t)NT * 1024;
  p.Vt = p.Kb + (size_t)NT * 1024;
  p.scores = (float*)region;
  p.x1b = p.Kb;
  if (off > ws_size) { fprintf(stderr, "workspace too small: need %zu have %zu\n", off, ws_size); return; }
  if (hipMemsetAsync(p.ctrl, 0, 4096, stream) != hipSuccess) { fprintf(stderr, "memset of the control words failed\n"); return; }
  void* args[] = {&p};
  hipError_t e = hipLaunchCooperativeKernel((void*)fwd_megakernel, dim3(grid_blocks), dim3(NTHREADS), args, LDS_BYTES, stream);
  if (e != hipSuccess) fprintf(stderr, "cooperative launch failed: %s (grid %d)\n", hipGetErrorString(e), grid_blocks);
}
```

```cpp
#include <hip/hip_runtime.h>
#include <hip/hip_cooperative_groups.h>
#include <cstdio>
#include <cstdint>
namespace cg = cooperative_groups;

#define DI __device__ __forceinline__
typedef unsigned short bf16_t;
typedef short bf16x8 __attribute__((ext_vector_type(8)));
typedef short s16x4 __attribute__((ext_vector_type(4)));
typedef float f32x16 __attribute__((ext_vector_type(16)));
typedef float f32x4 __attribute__((ext_vector_type(4)));
typedef float f32x2 __attribute__((ext_vector_type(2)));
typedef unsigned u32x4 __attribute__((ext_vector_type(4)));
typedef unsigned u32x2 __attribute__((ext_vector_type(2)));
typedef __bf16 bf2_t __attribute__((ext_vector_type(2)));

constexpr int DM = 2048, NB = 2, SEQ = 8192, NT = NB * SEQ;
constexpr int INC = 6144, NADA = 12288;
constexpr int NTHREADS = 512, NWAVES = 8;
constexpr int LDS_BYTES = 147456;

struct Params {
  const float* x; const float* c; const int* pos; const float* w_ada; const float* b_ada; const float* g1;
  const float* w_in; const float* conv_w; const float* qg; const float* kg; const float* lq1; const float* lk1;
  const float* lq2; const float* lk2; const float* subg; const float* w_out; const float* g2; const float* w_pq;
  const float* keys1; const float* keys2; const float* eu; const float* ev;
  float* out;
  unsigned* ctrl; float* mod; float* ropec; float* ropes;
  bf16_t* WinT; bf16_t* WoutT; bf16_t* WqkT; unsigned char* EU; unsigned char* EV; bf16_t* hbuf;
  float* su; float* sv;
  bf16_t* BCH; bf16_t* Qb; bf16_t* Kb; bf16_t* Vt; bf16_t* mixA;
  float* scores; int* tidx; float* tg;
  bf16_t* x1b;
};

DI unsigned pk_bf16(float lo, float hi) {
  f32x2 v = {lo, hi};
  bf2_t b = __builtin_convertvector(v, bf2_t);
  return __builtin_bit_cast(unsigned, b);
}
DI float bf_lo(unsigned u) { return __uint_as_float(u << 16); }
DI float bf_hi(unsigned u) { return __uint_as_float(u & 0xffff0000u); }
DI int crow(int i, int h) { return (i & 3) + 8 * (i >> 2) + 4 * h; }
DI int my_tid() { int t = threadIdx.x; asm volatile("" : "+v"(t)); return t; }
#define MFMA32(a, b, c) __builtin_amdgcn_mfma_f32_32x32x16_bf16((a), (b), (c), 0, 0, 0)

DI void ada_item(const Params& p, int item, float* lds) {
  const int tid = my_tid(), cgp = tid & 7, kl = tid >> 3;
  const int col = item * 32 + cgp * 4;
  f32x4 a0 = {0.f, 0.f, 0.f, 0.f}, a1 = {0.f, 0.f, 0.f, 0.f};
  for (int k = kl; k < DM; k += NTHREADS / 8) {
    const f32x4 w = *(const f32x4*)(p.w_ada + (size_t)k * NADA + col);
    const float c0 = p.c[k], c1 = p.c[DM + k];
    const float s0 = c0 / (1.f + __expf(-c0)), s1 = c1 / (1.f + __expf(-c1));
    a0 += w * s0; a1 += w * s1;
  }
  float* dst = lds + (kl * 8 + cgp) * 8;
  *(f32x4*)dst = a0; *(f32x4*)(dst + 4) = a1;
  __syncthreads();
  if (tid < 64) {
    const int b = tid >> 5, j = tid & 31, cg2 = j >> 2, e = j & 3;
    float s = 0.f;
    for (int q = 0; q < NTHREADS / 8; ++q) s += lds[(q * 8 + cg2) * 8 + b * 4 + e];
    p.mod[b * NADA + item * 32 + j] = s + p.b_ada[item * 32 + j];
  }
  __syncthreads();
}

DI void transpose_item(const float* __restrict__ W, bf16_t* __restrict__ Wt, int K, int N, int item2, float* lds0) {
  const int tfull = my_tid();
  const int tid = tfull & 255, item = item2 * 2 + (tfull >> 8);
  float* lds = lds0 + (tfull >> 8) * (64 * 65);
  const int ntn = N / 64;
  const int k0 = (item / ntn) * 64, n0 = (item % ntn) * 64;
  {
    const int r = tid >> 4, c4 = (tid & 15) * 4;
#pragma unroll
    for (int rr = 0; rr < 4; ++rr) {
      const int row = r + rr * 16;
      const f32x4 v = *(const f32x4*)(W + (size_t)(k0 + row) * N + n0 + c4);
      float* d = lds + row * 65 + c4;
      d[0] = v[0]; d[1] = v[1]; d[2] = v[2]; d[3] = v[3];
    }
  }
  __syncthreads();
  {
    const int n = tid >> 2, kq = (tid & 3) * 16;
    u32x4 o0, o1;
    float t[16];
#pragma unroll
    for (int j = 0; j < 16; ++j) t[j] = lds[(kq + j) * 65 + n];
    o0[0] = pk_bf16(t[0], t[1]); o0[1] = pk_bf16(t[2], t[3]); o0[2] = pk_bf16(t[4], t[5]); o0[3] = pk_bf16(t[6], t[7]);
    o1[0] = pk_bf16(t[8], t[9]); o1[1] = pk_bf16(t[10], t[11]); o1[2] = pk_bf16(t[12], t[13]); o1[3] = pk_bf16(t[14], t[15]);
    bf16_t* d = Wt + (size_t)(n0 + n) * K + k0 + kq;
    *(u32x4*)d = o0; *(u32x4*)(d + 8) = o1;
  }
  __syncthreads();
}

DI bf16x8 cvt8(const float* src) {
  const f32x4 a = *(const f32x4*)src, b = *(const f32x4*)(src + 4);
  u32x4 o; o[0] = pk_bf16(a[0], a[1]); o[1] = pk_bf16(a[2], a[3]); o[2] = pk_bf16(b[0], b[1]); o[3] = pk_bf16(b[2], b[3]);
  return __builtin_bit_cast(bf16x8, o);
}
DI void wqk_phase(const Params& p) {
  const int tid = my_tid();
  const int lane = tid & 63, r = lane & 31, h = lane >> 5;
  const int gw = __builtin_amdgcn_readfirstlane(blockIdx.x * NWAVES + (tid >> 6)), nw = gridDim.x * NWAVES;
  for (int it = gw; it < 2048; it += nw) {
    const int hh = it >> 7, mt = it & 3, kq = (it & 127) >> 2;
    const float* keys = ((hh & 1) ? p.keys2 : p.keys1) + (size_t)(mt * 32 + r) * 128 + h * 8;
    bf16x8 af[8];
#pragma unroll
    for (int ks = 0; ks < 8; ++ks) af[ks] = cvt8(keys + ks * 16);
#pragma unroll
    for (int nt = 0; nt < 2; ++nt) {
      const int krow = kq * 64 + nt * 32 + r;
      const float* wq = p.w_pq + (size_t)krow * DM + hh * 128 + h * 8;
      f32x16 acc;
#pragma unroll
      for (int i = 0; i < 16; ++i) acc[i] = 0.f;
#pragma unroll
      for (int ks = 0; ks < 8; ++ks) acc = MFMA32(af[ks], cvt8(wq + ks * 16), acc);
      bf16_t* dst = p.WqkT + (size_t)(hh * 128 + mt * 32) * DM + krow;
#pragma unroll
      for (int i = 0; i < 16; ++i) dst[(size_t)crow(i, h) * DM] = (bf16_t)(pk_bf16(acc[i], 0.f) & 0xffffu);
    }
  }
}

template <bool SRC_BF16>
DI void norm_mod_phase(const void* __restrict__ srcv, const float* __restrict__ g, const float* __restrict__ mod,
                       int which_shift, bf16_t* __restrict__ dst) {
  const int tid = my_tid();
  const int lane = tid & 63;
  const int gw = __builtin_amdgcn_readfirstlane(blockIdx.x * NWAVES + (tid >> 6)), nw = gridDim.x * NWAVES;
  f32x4 ga[8], sh[8];
  int cur_b = -1;
  for (int tok = gw; tok < NT; tok += nw) {
    const int b = tok >> 13;
    if (b != cur_b) {
      cur_b = b;
      const float* mb = mod + b * NADA + which_shift * DM;
#pragma unroll
      for (int j = 0; j < 8; ++j) {
        const int col = (j * 64 + lane) * 4;
        const f32x4 gg = *(const f32x4*)(g + col);
        const f32x4 sc = *(const f32x4*)(mb + DM + col);
        sh[j] = *(const f32x4*)(mb + col);
#pragma unroll
        for (int e = 0; e < 4; ++e) ga[j][e] = gg[e] * (1.f + sc[e]);
      }
    }
    f32x4 v[8];
    float ss = 0.f;
#pragma unroll
    for (int j = 0; j < 8; ++j) {
      if (SRC_BF16) {
        const u32x2 w = *(const u32x2*)((const bf16_t*)srcv + (size_t)tok * DM + (j * 64 + lane) * 4);
        v[j][0] = bf_lo(w[0]); v[j][1] = bf_hi(w[0]); v[j][2] = bf_lo(w[1]); v[j][3] = bf_hi(w[1]);
      } else {
        v[j] = *(const f32x4*)((const float*)srcv + (size_t)tok * DM + (j * 64 + lane) * 4);
      }
      ss += v[j][0] * v[j][0] + v[j][1] * v[j][1] + v[j][2] * v[j][2] + v[j][3] * v[j][3];
    }
#pragma unroll
    for (int m = 1; m < 64; m <<= 1) ss += __shfl_xor(ss, m);
    const float inv = rsqrtf(ss * (1.f / DM) + 1e-6f);
#pragma unroll
    for (int j = 0; j < 8; ++j) {
      const int col = (j * 64 + lane) * 4;
      f32x4 y;
#pragma unroll
      for (int e = 0; e < 4; ++e) y[e] = (v[j][e] * inv) * ga[j][e] + sh[j][e];
      u32x2 o; o[0] = pk_bf16(y[0], y[1]); o[1] = pk_bf16(y[2], y[3]);
      *(u32x2*)(dst + (size_t)tok * DM + col) = o;
    }
  }
}

DI unsigned fmap(float f) { const unsigned u = __float_as_uint(f); return u ^ ((u >> 31) ? 0xffffffffu : 0x80000000u); }
DI float funmap(unsigned u) { return __uint_as_float(u ^ ((u >> 31) ? 0x80000000u : 0xffffffffu)); }
#define INSERT16(list, key) { unsigned _k = (key); _Pragma("unroll") for (int _j = 0; _j < 16; ++_j) { const unsigned _hi = max(list[_j], _k); _k = min(list[_j], _k); list[_j] = _hi; } }

template <bool DESC>
DI void bitonic_sort16(unsigned (&a)[16]) {
#pragma unroll
  for (int k = 2; k <= 16; k <<= 1) {
#pragma unroll
    for (int j = k >> 1; j > 0; j >>= 1) {
#pragma unroll
      for (int i = 0; i < 16; ++i) {
        const int l = i ^ j;
        if (l > i) {
          const bool up = (((i & k) == 0) == DESC);
          const unsigned hi = max(a[i], a[l]), lo = min(a[i], a[l]);
          a[i] = up ? hi : lo; a[l] = up ? lo : hi;
        }
      }
    }
  }
}
DI void merge_top16(unsigned (&L)[16], const unsigned (&G)[16]) {
#pragma unroll
  for (int i = 0; i < 16; ++i) L[i] = max(L[i], G[i]);
#pragma unroll
  for (int j = 8; j > 0; j >>= 1) {
#pragma unroll
    for (int i = 0; i < 16; ++i) {
      const int l = i ^ j;
      if (l > i) { const unsigned hi = max(L[i], L[l]), lo = min(L[i], L[l]); L[i] = hi; L[l] = lo; }
    }
  }
}

constexpr int CAND_I[64] = {0, 0, 0, 0, 0, 0, 0, 0, 0, 0, 0, 0, 0, 0, 0, 0, 1, 1, 1, 1, 1, 1, 1, 1, 2, 2, 2, 2, 2, 3, 3, 3, 3, 4, 4, 4, 5, 5, 6, 6, 7, 7, 8, 9, 10, 11, 12, 13, 14, 15, 0, 0, 0, 0, 0, 0, 0, 0, 0, 0, 0, 0, 0, 0};
constexpr int CAND_J[64] = {0, 1, 2, 3, 4, 5, 6, 7, 8, 9, 10, 11, 12, 13, 14, 15, 0, 1, 2, 3, 4, 5, 6, 7, 0, 1, 2, 3, 4, 0, 1, 2, 3, 0, 1, 2, 0, 1, 0, 1, 0, 1, 0, 0, 0, 0, 0, 0, 0, 0, 0, 0, 0, 0, 0, 0, 0, 0, 0, 0, 0, 0, 0, 0};

DI void topk_merge4(const u32x4* pl, unsigned (&list)[16]) {
#pragma unroll
  for (int q = 0; q < 4; ++q) { const u32x4 v = pl[q]; list[4 * q] = v[0]; list[4 * q + 1] = v[1]; list[4 * q + 2] = v[2]; list[4 * q + 3] = v[3]; }
#pragma unroll
  for (int part = 1; part < 4; ++part) {
    unsigned g[16];
#pragma unroll
    for (int q = 0; q < 4; ++q) { const u32x4 v = pl[part * 4 + q]; g[15 - 4 * q] = v[0]; g[14 - 4 * q] = v[1]; g[13 - 4 * q] = v[2]; g[12 - 4 * q] = v[3]; }
    merge_top16(list, g);
  }
}
DI void topk_finish(const Params& p, unsigned (&list)[16], int tok, int hh, unsigned* my) {
  {
    unsigned other[16];
#pragma unroll
    for (int j = 0; j < 16; ++j) other[j] = (unsigned)__shfl_xor((int)list[j], 1);
    const bool first = (hh & 1) == 0;
    unsigned A[16], B[16];
#pragma unroll
    for (int j = 0; j < 16; ++j) { A[j] = first ? list[j] : other[j]; B[j] = first ? other[j] : list[j]; }
#pragma unroll
    for (int w = 0; w < 4; ++w) {
      my[w] = (A[4 * w] & 127u) | ((A[4 * w + 1] & 127u) << 8) | ((A[4 * w + 2] & 127u) << 16) | ((A[4 * w + 3] & 127u) << 24);
      my[4 + w] = (B[4 * w] & 127u) | ((B[4 * w + 1] & 127u) << 8) | ((B[4 * w + 2] & 127u) << 16) | ((B[4 * w + 3] & 127u) << 24);
    }
    float va[16], vb[16];
#pragma unroll
    for (int j = 0; j < 16; ++j) { va[j] = funmap(A[j] & ~127u); vb[j] = funmap(B[j] & ~127u); }
    unsigned top[16];
#pragma unroll
    for (int grp = 0; grp < 4; ++grp) {
      unsigned g[16];
#pragma unroll
      for (int t = 0; t < 16; ++t) {
        const int c = grp * 16 + t;
        g[t] = (c < 50) ? ((fmap(va[CAND_I[c]] + vb[CAND_J[c]]) & ~255u) | (unsigned)(CAND_I[c] * 16 + CAND_J[c])) : 0u;
      }
      if (grp == 0) {
        bitonic_sort16<true>(g);
#pragma unroll
        for (int j = 0; j < 16; ++j) top[j] = g[j];
      } else {
        bitonic_sort16<false>(g);
        merge_top16(top, g);
      }
    }
    float ev[16], sum = 0.f;
    const float mx = funmap(top[0] & ~255u);
#pragma unroll
    for (int j = 0; j < 16; ++j) { ev[j] = __expf(funmap(top[j] & ~255u) - mx); sum += ev[j]; }
    const float rs = 1.f / sum;
    const int head = hh >> 1;
    if (first) {
      int* dst = p.tidx + ((size_t)tok * 8 + head) * 16;
#pragma unroll
      for (int j = 0; j < 16; ++j) {
        const unsigned code = top[j] & 255u, ci = code >> 4, cj = code & 15u;
        const unsigned i1 = (my[ci >> 2] >> ((ci & 3u) * 8)) & 255u;
        const unsigned i2 = (my[4 + (cj >> 2)] >> ((cj & 3u) * 8)) & 255u;
        dst[j] = (int)(i1 * 128u + i2);
      }
    } else {
      float* dst = p.tg + ((size_t)tok * 8 + head) * 16;
#pragma unroll
      for (int j = 0; j < 16; ++j) dst[j] = ev[j] * rs;
    }
  }
}

template <int EPI>
DI void gemm_epilogue(const Params& p, const f32x16 (&acc)[4][2], int m_base, int tn, int wc, int r, int h) {
  const int n_base = tn * 128 + wc * 64;
  if (EPI == 1) {
    const int grp = tn >> 3;
    if (grp < 3) {
#pragma unroll
      for (int mt = 0; mt < 4; ++mt) {
        const int m = m_base + mt * 32 + r;
#pragma unroll
        for (int nt = 0; nt < 2; ++nt)
#pragma unroll
          for (int g = 0; g < 4; ++g) {
            const int n = n_base + nt * 32 + 8 * g + 4 * h;
            u32x2 o; o[0] = pk_bf16(acc[mt][nt][4 * g], acc[mt][nt][4 * g + 1]); o[1] = pk_bf16(acc[mt][nt][4 * g + 2], acc[mt][nt][4 * g + 3]);
            *(u32x2*)(p.BCH + (size_t)m * 3072 + n) = o;
          }
      }
    } else if (grp == 5) {
      const int head = tn - 40;
#pragma unroll
      for (int mt = 0; mt < 4; ++mt) {
        const int m = m_base + mt * 32 + r;
        const int b = m >> 13, s = m & 8191;
#pragma unroll
        for (int nt = 0; nt < 2; ++nt)
#pragma unroll
          for (int i = 0; i < 16; ++i) {
            const int e = wc * 64 + nt * 32 + crow(i, h);
            p.Vt[((size_t)(((b * 8 + head) * 128 + (s >> 6)) * 128 + e)) * 64 + (s & 63)] = (bf16_t)(pk_bf16(acc[mt][nt][i], 0.f) & 0xffffu);
          }
      }
    } else {
      const bool isq = (grp == 3);
      const int head = tn - (isq ? 24 : 32);
      const int half = wc;
      const float* gn = isq ? p.qg : p.kg;
      const float osc = isq ? (0.125f * 1.4426950408889634f) : 1.f;
      bf16_t* dbase = isq ? p.Qb : p.Kb;
#pragma unroll
      for (int mt = 0; mt < 4; ++mt) {
        const int m = m_base + mt * 32 + r;
        const int b = m >> 13, s = m & 8191;
        float ss = 0.f;
#pragma unroll
        for (int nt = 0; nt < 2; ++nt)
#pragma unroll
          for (int i = 0; i < 16; ++i) ss += acc[mt][nt][i] * acc[mt][nt][i];
        ss += __shfl_xor(ss, 32);
        const float inv = rsqrtf(ss * (1.f / 64.f) + 1e-6f);
        bf16_t* dst = dbase + ((size_t)(((b * 8 + head) * 2 + half)) * SEQ + s) * 64;
#pragma unroll
        for (int g = 0; g < 4; ++g) {
          const int d0 = 8 * g + 4 * h;
          const f32x4 cs = *(const f32x4*)(p.ropec + (size_t)m * 32 + d0);
          const f32x4 sn = *(const f32x4*)(p.ropes + (size_t)m * 32 + d0);
          const f32x4 ga = *(const f32x4*)(gn + d0);
          const f32x4 gb = *(const f32x4*)(gn + 32 + d0);
          float o0[4], o1[4];
#pragma unroll
          for (int j = 0; j < 4; ++j) {
            const float y0 = acc[mt][0][4 * g + j] * inv * ga[j];
            const float y1 = acc[mt][1][4 * g + j] * inv * gb[j];
            o0[j] = (y0 * cs[j] - y1 * sn[j]) * osc;
            o1[j] = (y1 * cs[j] + y0 * sn[j]) * osc;
          }
          u32x2 a; a[0] = pk_bf16(o0[0], o0[1]); a[1] = pk_bf16(o0[2], o0[3]);
          u32x2 bq; bq[0] = pk_bf16(o1[0], o1[1]); bq[1] = pk_bf16(o1[2], o1[3]);
          *(u32x2*)(dst + d0) = a;
          *(u32x2*)(dst + 32 + d0) = bq;
        }
      }
    }
  } else if (EPI == 2) {
#pragma unroll
    for (int mt = 0; mt < 4; ++mt) {
      const int m = m_base + mt * 32 + r;
      const int b = m >> 13;
      const float* gate = p.mod + b * NADA + 2 * DM;
#pragma unroll
      for (int nt = 0; nt < 2; ++nt)
#pragma unroll
        for (int g = 0; g < 4; ++g) {
          const int n = n_base + nt * 32 + 8 * g + 4 * h;
          const f32x4 xv = *(const f32x4*)(p.x + (size_t)m * DM + n);
          const f32x4 gt = *(const f32x4*)(gate + n);
          f32x4 o;
#pragma unroll
          for (int j = 0; j < 4; ++j) o[j] = xv[j] + gt[j] * acc[mt][nt][4 * g + j];
          u32x2 ob; ob[0] = pk_bf16(o[0], o[1]); ob[1] = pk_bf16(o[2], o[3]);
          *(u32x2*)(p.x1b + (size_t)m * DM + n) = ob;
        }
    }
  } else {
    unsigned* plist = (unsigned*)p.scores;
#pragma unroll
    for (int mt = 0; mt < 4; ++mt) {
      const int m = m_base + mt * 32 + r;
      unsigned a[16], b[16];
#pragma unroll
      for (int i = 0; i < 16; ++i) {
        a[i] = (fmap(acc[mt][0][i]) & ~127u) | (unsigned)(wc * 64 + crow(i, h));
        b[i] = (fmap(acc[mt][1][i]) & ~127u) | (unsigned)(wc * 64 + 32 + crow(i, h));
      }
      bitonic_sort16<true>(a);
      bitonic_sort16<false>(b);
      merge_top16(a, b);
      unsigned* dst = plist + (((size_t)m * 16 + tn) * 4 + (wc * 2 + h)) * 16;
#pragma unroll
      for (int q = 0; q < 4; ++q) { u32x4 o; o[0] = a[4 * q]; o[1] = a[4 * q + 1]; o[2] = a[4 * q + 2]; o[3] = a[4 * q + 3]; *(u32x4*)(dst + 4 * q) = o; }
    }
  }
}

template <int EPI>
DI void gemm_phase(const Params& p, const bf16_t* __restrict__ A, const bf16_t* __restrict__ Bt, int N, char* lds) {
  constexpr int K = DM;
  const int tid = my_tid(), lane = tid & 63, wave = tid >> 6, wr = wave >> 2, wc = wave & 3;
  const int r = lane & 31, h = lane >> 5;
  const int nNt = N / 256;
  const int stM = (NT / 256) / 8, stN = nNt / 4, nST = stM * stN;
  const int G = gridDim.x;
  const int xcd = blockIdx.x & 7, local = blockIdx.x >> 3;
  const int nb = (G - xcd + 7) >> 3;
  const int cnt = (nST - xcd + 7) >> 3;
  const int srow = tid >> 3, sc = tid & 7;
  for (int e = local; e < cnt * 32; e += nb) {
    const int st = xcd + 8 * (e >> 5), w = e & 31;
    const int stm = st % stM, stn = st / stM;
    const int tm = stm * 8 + (w & 7), tn = stn * 4 + (w >> 3);
    f32x16 acc[4][2];
#pragma unroll
    for (int a = 0; a < 4; ++a)
#pragma unroll
      for (int b = 0; b < 2; ++b)
#pragma unroll
        for (int i = 0; i < 16; ++i) acc[a][b][i] = 0.f;
    const bf16_t* Ag = A + (size_t)(tm * 256 + srow) * K + ((sc ^ ((srow >> 1) & 7)) * 8);
    const bf16_t* Bg = Bt + (size_t)(tn * 256 + srow) * K + ((sc ^ ((srow >> 1) & 7)) * 8);
#define GLDS(BUF, KT) _Pragma("unroll") for (int i = 0; i < 4; ++i) { \
      __builtin_amdgcn_global_load_lds((const unsigned*)(Ag + (size_t)i * 64 * K + (KT) * 64), (unsigned*)(lds + (BUF) * 65536 + tid * 16 + i * 8192), 16, 0, 0); \
      __builtin_amdgcn_global_load_lds((const unsigned*)(Bg + (size_t)i * 64 * K + (KT) * 64), (unsigned*)(lds + (BUF) * 65536 + 32768 + tid * 16 + i * 8192), 16, 0, 0); }
    GLDS(0, 0)
    __syncthreads();
#pragma unroll 1
    for (int kt = 0; kt < K / 64; ++kt) {
      const int cur = kt & 1;
      if (kt + 1 < K / 64) { GLDS(cur ^ 1, kt + 1) }
      const char* sA = lds + cur * 65536;
      const char* sB = sA + 32768;
#pragma unroll
      for (int ks = 0; ks < 4; ++ks) {
        const int coff = ((ks * 2 + h) ^ ((r >> 1) & 7)) << 4;
        bf16x8 af[4], bfr[2];
#pragma unroll
        for (int mt = 0; mt < 4; ++mt) af[mt] = *(const bf16x8*)(sA + (wr * 128 + mt * 32 + r) * 128 + coff);
#pragma unroll
        for (int nt = 0; nt < 2; ++nt) bfr[nt] = *(const bf16x8*)(sB + (wc * 64 + nt * 32 + r) * 128 + coff);
#pragma unroll
        for (int mt = 0; mt < 4; ++mt)
#pragma unroll
          for (int nt = 0; nt < 2; ++nt) acc[mt][nt] = MFMA32(bfr[nt], af[mt], acc[mt][nt]);
      }
      __syncthreads();
    }
#undef GLDS
    if (EPI != 3) {
      gemm_epilogue<EPI>(p, acc, tm * 256 + wr * 128, tn * 2 + (wc >> 1), wc & 1, r, h);
    } else {
#pragma unroll
      for (int mt = 0; mt < 4; ++mt) {
        const int row = wr * 128 + mt * 32 + r;
        unsigned a[16], b[16];
#pragma unroll
        for (int i = 0; i < 16; ++i) {
          a[i] = (fmap(acc[mt][0][i]) & ~127u) | (unsigned)((wc & 1) * 64 + crow(i, h));
          b[i] = (fmap(acc[mt][1][i]) & ~127u) | (unsigned)((wc & 1) * 64 + 32 + crow(i, h));
        }
        bitonic_sort16<true>(a);
        bitonic_sort16<false>(b);
        merge_top16(a, b);
        unsigned* dst = (unsigned*)lds + (((row * 2 + (wc >> 1)) * 4 + ((wc & 1) * 2 + h)) * 16);
#pragma unroll
        for (int q = 0; q < 4; ++q) { u32x4 o; o[0] = a[4 * q]; o[1] = a[4 * q + 1]; o[2] = a[4 * q + 2]; o[3] = a[4 * q + 3]; *(u32x4*)(dst + 4 * q) = o; }
      }
      __syncthreads();
      {
        unsigned list[16];
        topk_merge4((const u32x4*)((const unsigned*)lds + tid * 64), list);
        topk_finish(p, list, tm * 256 + (tid >> 1), tn * 2 + (tid & 1), (unsigned*)(lds + 131072) + tid * 8);
      }
      __syncthreads();
    }
  }
}

typedef float v16f_t __attribute__((ext_vector_type(16)));
typedef float v32f_t __attribute__((ext_vector_type(32)));
typedef _Float16 v32h_t __attribute__((ext_vector_type(32)));
typedef unsigned v6u_t __attribute__((ext_vector_type(6)));
constexpr unsigned EROW = 1536u;
DI void fp6_rows_phase(const Params& p) {
  const int tid = my_tid();
  const int lane = tid & 63;
  const int gw = __builtin_amdgcn_readfirstlane(blockIdx.x * NWAVES + (tid >> 6)), nw = gridDim.x * NWAVES;
  f32x4 vn[8];
  if (gw < 32768) {
    const float* s0 = (gw >= 16384 ? p.ev : p.eu) + (size_t)(gw & 16383) * DM;
#pragma unroll
    for (int j = 0; j < 8; ++j) vn[j] = *(const f32x4*)(s0 + (unsigned)((j * 64 + lane) * 4));
  }
  for (int row = gw; row < 32768; row += nw) {
    const bool second = row >= 16384;
    const int r = row & 16383;
    f32x4 v[8];
#pragma unroll
    for (int j = 0; j < 8; ++j) v[j] = vn[j];
    if (row + nw < 32768) {
      const int rn = row + nw;
      const float* s1 = (rn >= 16384 ? p.ev : p.eu) + (size_t)(rn & 16383) * DM;
#pragma unroll
      for (int j = 0; j < 8; ++j) vn[j] = *(const f32x4*)(s1 + (unsigned)((j * 64 + lane) * 4));
    }
    float mx = 0.f;
#pragma unroll
    for (int j = 0; j < 8; ++j)
      mx = fmaxf(mx, fmaxf(fmaxf(fabsf(v[j][0]), fabsf(v[j][1])), fmaxf(fabsf(v[j][2]), fabsf(v[j][3]))));
#pragma unroll
    for (int m = 1; m < 64; m <<= 1) mx = fmaxf(mx, __shfl_xor(mx, m));
    const float sc = mx > 0.f ? 7.0f / mx : 1.f;
    const float inv = mx > 0.f ? mx * (1.f / 7.0f) : 1.f;
    v32h_t a;
#pragma unroll
    for (int j = 0; j < 8; ++j)
#pragma unroll
      for (int e = 0; e < 4; ++e) a[j * 4 + e] = (_Float16)(v[j][e] * sc);
    const v6u_t pk = __builtin_amdgcn_cvt_scalef32_pk32_fp6_f16(a, 1.0f);
    unsigned char* dst = (second ? p.EV : p.EU) + (size_t)r * EROW;
    u32x4 w0; w0[0] = pk[0]; w0[1] = pk[1]; w0[2] = pk[2]; w0[3] = pk[3];
    u32x2 w1; w1[0] = pk[4]; w1[1] = pk[5];
    *(u32x4*)(dst + (unsigned)lane * 16u) = w0;
    *(u32x2*)(dst + 1024u + (unsigned)lane * 8u) = w1;
    if (lane == 0) (second ? p.sv : p.su)[r] = inv;
  }
}

DI void conv_phase(const Params& p) {
  const int tid = my_tid();
  const int ch = (tid & 127) * 8, tsub = tid >> 7;
  float w0[8], w1[8], w2[8];
#pragma unroll
  for (int j = 0; j < 8; ++j) { w0[j] = p.conv_w[ch + j]; w1[j] = p.conv_w[1024 + ch + j]; w2[j] = p.conv_w[2048 + ch + j]; }
  for (int unit = blockIdx.x; unit < NT / 64; unit += gridDim.x) {
    const int t0 = unit * 64 + tsub * 16;
    float z1[8], z2[8];
#pragma unroll
    for (int j = 0; j < 8; ++j) { z1[j] = 0.f; z2[j] = 0.f; }
    const int s0 = t0 & 8191;
    for (int back = 2; back >= 1; --back) {
      if (s0 - back >= 0) {
        const bf16_t* rowp = p.BCH + (size_t)(t0 - back) * 3072;
        const u32x4 cv = *(const u32x4*)(rowp + 1024 + ch);
        const u32x4 hv = *(const u32x4*)(rowp + 2048 + ch);
#pragma unroll
        for (int q = 0; q < 4; ++q) {
          const float a = bf_lo(cv[q]) * bf_lo(hv[q]), b = bf_hi(cv[q]) * bf_hi(hv[q]);
          if (back == 2) { z2[2 * q] = a; z2[2 * q + 1] = b; } else { z1[2 * q] = a; z1[2 * q + 1] = b; }
        }
      }
    }
    for (int tt = 0; tt < 16; ++tt) {
      const int t = t0 + tt;
      const bf16_t* rowp = p.BCH + (size_t)t * 3072;
      const u32x4 bv = *(const u32x4*)(rowp + ch);
      const u32x4 cv = *(const u32x4*)(rowp + 1024 + ch);
      const u32x4 hv = *(const u32x4*)(rowp + 2048 + ch);
      float z0[8], y[8];
#pragma unroll
      for (int q = 0; q < 4; ++q) {
        z0[2 * q] = bf_lo(cv[q]) * bf_lo(hv[q]); z0[2 * q + 1] = bf_hi(cv[q]) * bf_hi(hv[q]);
      }
#pragma unroll
      for (int q = 0; q < 4; ++q) {
        y[2 * q] = bf_lo(bv[q]) * (w0[2 * q] * z2[2 * q] + w1[2 * q] * z1[2 * q] + w2[2 * q] * z0[2 * q]);
        y[2 * q + 1] = bf_hi(bv[q]) * (w0[2 * q + 1] * z2[2 * q + 1] + w1[2 * q + 1] * z1[2 * q + 1] + w2[2 * q + 1] * z0[2 * q + 1]);
      }
      u32x4 o;
#pragma unroll
      for (int q = 0; q < 4; ++q) o[q] = pk_bf16(y[2 * q], y[2 * q + 1]);
      *(u32x4*)(p.mixA + (size_t)t * DM + ch) = o;
#pragma unroll
      for (int j = 0; j < 8; ++j) { z2[j] = z1[j]; z1[j] = z0[j]; }
    }
  }
}

DI void attn_phase(const Params& p, char* lds, int* s_item, float* s_lam) {
  const int tid = my_tid(), lane = tid & 63, wave = tid >> 6;
  const int r = lane & 31, h = lane >> 5;
  float d1 = 0.f, d2 = 0.f, mq = 0.f, mk = 0.f;
  for (int i = 0; i < 64; ++i) {
    d1 += p.lq1[i] * p.lk1[i]; d2 += p.lq2[i] * p.lk2[i];
    mq = fmaxf(mq, fabsf(p.qg[i])); mk = fmaxf(mk, fabsf(p.kg[i]));
  }
  const float lam_init = 0.2f;
  const float negM2 = -(8.f * mq * mk * 1.4426950408889634f * 1.02f + 0.25f);
  if (tid == 0) s_lam[0] = __expf(d1) - __expf(d2) + lam_init;
  char* Qs = lds;
  char* Ks = lds + 73728;
  char* Vs = lds + 92160;
  int n_items = 0;
  bool did_conv = false;
  while (true) {
    if (tid == 0) *s_item = (int)atomicAdd(&p.ctrl[1], 1u);
    __syncthreads();
    const int item = __builtin_amdgcn_readfirstlane(*s_item);
    __syncthreads();
    if (item >= 512) break;
    ++n_items;
    const int qi = 31 - (item >> 4), bh = item & 15;
    const int q0 = qi * 256;
    unsigned thr = (unsigned)((tid >> 3) * 128 + (tid & 7) * 16);
    asm volatile("" : "+v"(thr));
    const char* Qg = (const char*)p.Qb + (size_t)(bh * 2) * SEQ * 128;
    const char* Kg = (const char*)p.Kb + (size_t)(bh * 2) * SEQ * 128;
    const char* Vg = (const char*)p.Vt + (size_t)bh * 128 * SEQ * 2;
    {
      int t2 = tid; asm volatile("" : "+v"(t2));
      char* qst = Qs + (t2 >> 3) * 144 + (t2 & 7) * 16;
#pragma unroll
      for (int i = 0; i < 8; ++i) {
        const u32x4 v = *(const u32x4*)(Qg + ((size_t)(i >> 2) * SEQ + q0 + (i & 3) * 64) * 128 + thr);
        *(u32x4*)(qst + (i >> 2) * 36864 + (i & 3) * 64 * 144) = v;
      }
    }
    const int nkt = 4 * qi + 4;
    u32x4 rk[2], rv[2];
    auto prefetch = [&](int kt) {
      const char* kb = Kg + (size_t)kt * 64 * 128;
      const char* vb = Vg + (size_t)kt * 16384;
#pragma unroll
      for (int i = 0; i < 2; ++i) {
        rk[i] = *(const u32x4*)(kb + ((size_t)i * SEQ) * 128 + thr);
        rv[i] = *(const u32x4*)(vb + i * 64 * 128 + thr);
      }
    };
    prefetch(0);
    f32x16 O0[4], O1[4];
#pragma unroll
    for (int et = 0; et < 4; ++et)
#pragma unroll
      for (int i = 0; i < 16; ++i) { O0[et][i] = 0.f; O1[et][i] = 0.f; }
    float l0 = 0.f, l1 = 0.f;
    const int qglob = q0 + wave * 32 + r;
    char* kst = Ks + (tid >> 3) * 144 + (tid & 7) * 16;
    char* vst = Vs + (tid >> 3) * 144 + ((tid & 7) >> 1) * 32 + (tid & 1) * 8;
    const char* kfr0 = Ks + r * 144 + h * 16;
    const char* qfr = Qs + (wave * 32 + r) * 144 + h * 16;
    const char* vfr0 = Vs + r * 144 + h * 16;
#define KV_STORE(BUF) _Pragma("unroll") for (int i = 0; i < 2; ++i) { \
        *(u32x4*)(kst + (BUF) * 36864 + i * 9216) = rk[i]; \
        u32x2 lo, hi; lo[0] = rv[i][0]; lo[1] = rv[i][1]; hi[0] = rv[i][2]; hi[1] = rv[i][3]; \
        *(u32x2*)(vst + (BUF) * 36864 + i * 64 * 144) = lo; \
        *(u32x2*)(vst + (BUF) * 36864 + i * 64 * 144 + 16) = hi; }
    KV_STORE(0)
    if (nkt > 1) prefetch(1);
    __syncthreads();
#pragma unroll 1
    for (int kt = 0; kt < nkt; ++kt) {
      const int cur = kt & 1;
      const char* kfr = kfr0 + cur * 36864;
      const char* vfr = vfr0 + cur * 36864;
      const int key0 = kt * 64;
      const bool diag = (kt >= 4 * qi);
#pragma unroll
      for (int kk = 0; kk < 2; ++kk) {
        const int kbase = key0 + kk * 32;
        if (kbase > q0 + wave * 32 + 31) continue;
        bf16x8 P0[2], P1[2];
        bf16x8 vf[4];
#pragma unroll
        for (int hf = 0; hf < 2; ++hf) {
          bf16x8 kf[4], qf[4];
#pragma unroll
          for (int ks = 0; ks < 4; ++ks) {
            kf[ks] = *(const bf16x8*)(kfr + hf * 9216 + kk * 32 * 144 + ks * 32);
            qf[ks] = *(const bf16x8*)(qfr + hf * 36864 + ks * 32);
          }
          __builtin_amdgcn_sched_barrier(0);
          f32x16 X;
#pragma unroll
          for (int i = 0; i < 16; ++i) X[i] = negM2;
#pragma unroll
          for (int ks = 0; ks < 4; ++ks) X = MFMA32(kf[ks], qf[ks], X);
          if (hf == 1) {
#pragma unroll
            for (int et = 0; et < 2; ++et)
#pragma unroll
              for (int s = 0; s < 2; ++s) vf[et * 2 + s] = *(const bf16x8*)(vfr + et * 32 * 144 + (kk * 2 + s) * 32);
          }
          __builtin_amdgcn_sched_barrier(0);
          float ls = 0.f;
#pragma unroll
          for (int i = 0; i < 16; ++i) {
            float e0 = __builtin_amdgcn_exp2f(X[i]);
            if (diag) e0 = ((kbase + crow(i, h)) <= qglob) ? e0 : 0.f;
            X[i] = e0; ls += e0;
          }
#pragma unroll
          for (int s = 0; s < 2; ++s) {
            u32x4 a;
#pragma unroll
            for (int j = 0; j < 4; ++j) a[j] = pk_bf16(X[8 * s + 2 * j], X[8 * s + 2 * j + 1]);
            if (hf == 0) P0[s] = __builtin_bit_cast(bf16x8, a); else P1[s] = __builtin_bit_cast(bf16x8, a);
          }
          if (hf == 0) l0 += ls; else l1 += ls;
          __builtin_amdgcn_sched_barrier(0);
        }
        bf16x8 vg[4];
#pragma unroll
        for (int et = 2; et < 4; ++et)
#pragma unroll
          for (int s = 0; s < 2; ++s) vg[(et - 2) * 2 + s] = *(const bf16x8*)(vfr + et * 32 * 144 + (kk * 2 + s) * 32);
        __builtin_amdgcn_sched_barrier(0);
#pragma unroll
        for (int et = 0; et < 2; ++et) {
#pragma unroll
          for (int s = 0; s < 2; ++s) {
            O0[et] = MFMA32(vf[et * 2 + s], P0[s], O0[et]);
            O1[et] = MFMA32(vf[et * 2 + s], P1[s], O1[et]);
          }
        }
        __builtin_amdgcn_sched_barrier(0);
#pragma unroll
        for (int et = 2; et < 4; ++et) {
#pragma unroll
          for (int s = 0; s < 2; ++s) {
            O0[et] = MFMA32(vg[(et - 2) * 2 + s], P0[s], O0[et]);
            O1[et] = MFMA32(vg[(et - 2) * 2 + s], P1[s], O1[et]);
          }
        }
        __builtin_amdgcn_sched_barrier(0);
      }
      if (kt + 1 < nkt) {
        if (cur == 0) { KV_STORE(1) } else { KV_STORE(0) }
        if (kt + 2 < nkt) prefetch(kt + 2);
      }
      __syncthreads();
    }
#undef KV_STORE
    l0 += __shfl_xor(l0, 32); l1 += __shfl_xor(l1, 32);
    const float i0 = 1.f / l0, i1 = s_lam[0] / l1;
    float ss = 0.f;
#pragma unroll
    for (int et = 0; et < 4; ++et)
#pragma unroll
      for (int i = 0; i < 16; ++i) { const float o = O0[et][i] * i0 - O1[et][i] * i1; O0[et][i] = o; ss += o * o; }
    ss += __shfl_xor(ss, 32);
    const float rinv = rsqrtf(ss * (1.f / 128.f) + 1e-5f) * (1.f - lam_init);
    const int t = (bh >> 3) * SEQ + qglob;
    bf16_t* dst = p.mixA + (size_t)t * DM + 1024 + (bh & 7) * 128;
#pragma unroll
    for (int et = 0; et < 4; ++et)
#pragma unroll
      for (int g = 0; g < 4; ++g) {
        const int e = et * 32 + 8 * g + 4 * h;
        const f32x4 sg = *(const f32x4*)(p.subg + e);
        u32x2 o;
        o[0] = pk_bf16(O0[et][4 * g] * rinv * sg[0], O0[et][4 * g + 1] * rinv * sg[1]);
        o[1] = pk_bf16(O0[et][4 * g + 2] * rinv * sg[2], O0[et][4 * g + 3] * rinv * sg[3]);
        *(u32x2*)(dst + e) = o;
      }
    if (!did_conv) { did_conv = true; conv_phase(p); fp6_rows_phase(p); }
  }
  if (!did_conv) { conv_phase(p); fp6_rows_phase(p); }
}

constexpr int bitrev4(int j) { return ((j & 1) << 3) | ((j & 2) << 1) | ((j & 4) >> 1) | ((j & 8) >> 3); }
DI void expert_phase(const Params& p) {
  const int tid = my_tid();
  const int lane = tid & 63;
  const int gw = __builtin_amdgcn_readfirstlane(blockIdx.x * NWAVES + (tid >> 6)), nw = gridDim.x * NWAVES;
  const int b0 = lane & 1, b1 = (lane >> 1) & 1, b2 = (lane >> 2) & 1, b3 = (lane >> 3) & 1;
  const int mypick = b0 * 8 + b1 * 4 + b2 * 2 + b3;
  const unsigned loff16 = (unsigned)lane * 16u, loff8 = 1024u + (unsigned)lane * 8u;
  for (int tok = gw; tok < NT; tok += nw) {
    unsigned ln = (unsigned)lane;
    asm volatile("" : "+v"(ln));
    f32x2 hf[16];
#pragma unroll
    for (int j = 0; j < 8; ++j) {
      const u32x2 w = *(const u32x2*)((const char*)(p.hbuf + (size_t)tok * DM) + (ln * 8u + (unsigned)(j * 512)));
      f32x2 t0 = {bf_lo(w[0]), bf_hi(w[0])}, t1 = {bf_lo(w[1]), bf_hi(w[1])};
      hf[2 * j] = t0; hf[2 * j + 1] = t1;
    }
    const int* tip = p.tidx + (size_t)tok * 128;
    const float* tgp = p.tg + (size_t)tok * 128;
    const int il = tip[ln], ih = tip[64u + ln];
    const float gl = tgp[ln], gh = tgp[64u + ln];
    f32x2 out[16];
#pragma unroll
    for (int k = 0; k < 16; ++k) { f32x2 z = {0.f, 0.f}; out[k] = z; }
#pragma unroll 1
    for (int head = 0; head < 8; ++head) {
      const int isel = head < 4 ? il : ih;
      const float gsel = head < 4 ? gl : gh;
      const int lbase = (head & 3) * 16;
      const int emy = __shfl(isel, lbase + mypick);
      const float suv = p.su[emy], svv = p.sv[emy];
      float part[16];
#pragma unroll
      for (int j = 0; j < 16; ++j) {
        const int e = __builtin_amdgcn_readlane(isel, lbase + j);
        const char* urow = (const char*)p.EU + (size_t)(unsigned)e * EROW;
        const u32x4 w0 = *(const u32x4*)(urow + loff16);
        const u32x2 w1 = *(const u32x2*)(urow + loff8);
        v6u_t pk; pk[0] = w0[0]; pk[1] = w0[1]; pk[2] = w0[2]; pk[3] = w0[3]; pk[4] = w1[0]; pk[5] = w1[1];
        const v32f_t u = __builtin_amdgcn_cvt_scalef32_pk32_f32_fp6(pk, 1.0f);
        f32x2 acc = {0.f, 0.f};
#pragma unroll
        for (int q = 0; q < 16; ++q) { f32x2 t = {u[2 * q], u[2 * q + 1]}; acc = t * hf[q] + acc; }
        part[j] = acc.x + acc.y;
        if ((j & 3) == 3) __builtin_amdgcn_sched_barrier(0);
      }
#pragma unroll
      for (int j = 0; j < 8; ++j) {
        const float send = b0 ? part[j] : part[j + 8];
        const float keep = b0 ? part[j + 8] : part[j];
        part[j] = keep + __shfl_xor(send, 1);
      }
#pragma unroll
      for (int j = 0; j < 4; ++j) {
        const float send = b1 ? part[j] : part[j + 4];
        const float keep = b1 ? part[j + 4] : part[j];
        part[j] = keep + __shfl_xor(send, 2);
      }
#pragma unroll
      for (int j = 0; j < 2; ++j) {
        const float send = b2 ? part[j] : part[j + 2];
        const float keep = b2 ? part[j + 2] : part[j];
        part[j] = keep + __shfl_xor(send, 4);
      }
      {
        const float send = b3 ? part[0] : part[1];
        const float keep = b3 ? part[1] : part[0];
        part[0] = keep + __shfl_xor(send, 8);
      }
      float a = part[0];
      a += __shfl_xor(a, 16);
      a += __shfl_xor(a, 32);
      a *= suv;
      const float gm = __shfl(gsel, lbase + mypick);
      const float wgt = 0.5f * a * (1.f + erff(a * 0.70710678118654752f)) * gm * svv;
#pragma unroll
      for (int j = 0; j < 16; ++j) {
        const int e = __builtin_amdgcn_readlane(isel, lbase + j);
        const float wj = __uint_as_float((unsigned)__builtin_amdgcn_readlane((int)__float_as_uint(wgt), bitrev4(j)));
        const f32x2 wj2 = {wj, wj};
        const char* vrow = (const char*)p.EV + (size_t)(unsigned)e * EROW;
        const u32x4 w0 = *(const u32x4*)(vrow + loff16);
        const u32x2 w1 = *(const u32x2*)(vrow + loff8);
        v6u_t pk; pk[0] = w0[0]; pk[1] = w0[1]; pk[2] = w0[2]; pk[3] = w0[3]; pk[4] = w1[0]; pk[5] = w1[1];
        const v32f_t v = __builtin_amdgcn_cvt_scalef32_pk32_f32_fp6(pk, 1.0f);
#pragma unroll
        for (int q = 0; q < 16; ++q) { f32x2 t = {v[2 * q], v[2 * q + 1]}; out[q] = wj2 * t + out[q]; }
        if ((j & 3) == 3) __builtin_amdgcn_sched_barrier(0);
      }
    }
    const float* gate = p.mod + (tok >> 13) * NADA + 5 * DM;
    unsigned ln2 = (unsigned)lane;
    asm volatile("" : "+v"(ln2));
    float* orow = p.out + (size_t)tok * DM;
#pragma unroll
    for (int j = 0; j < 8; ++j) {
      const unsigned col = (unsigned)(j * 256) + ln2 * 4u;
      const u32x2 xw = *(const u32x2*)(p.x1b + (size_t)tok * DM + col);
      f32x4 xv; xv[0] = bf_lo(xw[0]); xv[1] = bf_hi(xw[0]); xv[2] = bf_lo(xw[1]); xv[3] = bf_hi(xw[1]);
      const f32x4 gt = *(const f32x4*)(gate + col);
      f32x4 o;
      o[0] = xv[0] + gt[0] * out[2 * j].x;
      o[1] = xv[1] + gt[1] * out[2 * j].y;
      o[2] = xv[2] + gt[2] * out[2 * j + 1].x;
      o[3] = xv[3] + gt[3] * out[2 * j + 1].y;
      *(f32x4*)(orow + col) = o;
    }
  }
}


DI void grid_barrier(unsigned* ctrl, unsigned k) {
  __syncthreads();
  if (my_tid() == 0) {
    __threadfence();
    unsigned bid = blockIdx.x, G = gridDim.x;
    asm volatile("" : "+s"(bid), "+s"(G));
    const unsigned g = bid & 7;
    const unsigned nbg = (G - g + 7) >> 3;
    const unsigned prev = __hip_atomic_fetch_add(&ctrl[64 + g * 64], 1u, __ATOMIC_RELAXED, __HIP_MEMORY_SCOPE_AGENT);
    if (prev + 1 == nbg * (k + 1)) {
      const unsigned p2 = __hip_atomic_fetch_add(&ctrl[640], 1u, __ATOMIC_RELAXED, __HIP_MEMORY_SCOPE_AGENT);
      if (p2 + 1 == 8u * (k + 1)) __hip_atomic_store(&ctrl[704], k + 1, __ATOMIC_RELAXED, __HIP_MEMORY_SCOPE_AGENT);
    }
    while (__hip_atomic_load(&ctrl[704], __ATOMIC_RELAXED, __HIP_MEMORY_SCOPE_AGENT) < k + 1) __builtin_amdgcn_s_sleep(2);
    __threadfence();
  }
  __syncthreads();
}

typedef const Params __attribute__((address_space(4)))* KParams;
#define FRESH_PARAMS(q) asm volatile("" : "+s"(kp)); Params q; __builtin_memcpy(&q, kp, sizeof(Params));

__global__ void __launch_bounds__(NTHREADS, 2) fwd_megakernel(Params p_unused) {
  cg::grid_group grid = cg::this_grid();
  extern __shared__ __attribute__((aligned(16))) char lds[];
  __shared__ int s_item;
  __shared__ float s_lam;
  const int tid = my_tid();
  const int G = gridDim.x;
  KParams kp = (KParams)__builtin_amdgcn_kernarg_segment_ptr();
  if (gridDim.y == 0x7fffu) grid.sync();
  {
    FRESH_PARAMS(p)
    for (int it = blockIdx.x; it < 384; it += G) ada_item(p, it, (float*)lds);
    wqk_phase(p);
    for (int it = blockIdx.x; it < (DM / 64) * (INC / 64) / 2; it += G) transpose_item(p.w_in, p.WinT, DM, INC, it, (float*)lds);
    for (int it = blockIdx.x; it < (DM / 64) * (DM / 64) / 2; it += G) transpose_item(p.w_out, p.WoutT, DM, DM, it, (float*)lds);
    for (int i = blockIdx.x * NTHREADS + tid; i < NT * 32; i += G * NTHREADS) {
      const int t = i >> 5, f = i & 31;
      const float inv_freq = powf(10000.f, -(float)(2 * f) / 64.f);
      const float ang = (float)p.pos[t] * inv_freq;
      float s, c;
      sincosf(ang, &s, &c);
      p.ropec[i] = c; p.ropes[i] = s;
    }
  }
  { FRESH_PARAMS(pb) grid_barrier(pb.ctrl, 0u); }
  { FRESH_PARAMS(p) norm_mod_phase<false>(p.x, p.g1, p.mod, 0, p.hbuf); }
  { FRESH_PARAMS(pb) grid_barrier(pb.ctrl, 1u); }
  { FRESH_PARAMS(p) gemm_phase<1>(p, p.hbuf, p.WinT, INC, lds); }
  { FRESH_PARAMS(pb) grid_barrier(pb.ctrl, 2u); }
  { FRESH_PARAMS(p) attn_phase(p, lds, &s_item, &s_lam); }
  { FRESH_PARAMS(pb) grid_barrier(pb.ctrl, 3u); }
  { FRESH_PARAMS(p) gemm_phase<2>(p, p.mixA, p.WoutT, DM, lds); }
  { FRESH_PARAMS(pb) grid_barrier(pb.ctrl, 4u); }
  { FRESH_PARAMS(p) norm_mod_phase<true>(p.x1b, p.g2, p.mod, 3, p.hbuf); }
  { FRESH_PARAMS(pb) grid_barrier(pb.ctrl, 5u); }
  { FRESH_PARAMS(p) gemm_phase<3>(p, p.hbuf, p.WqkT, DM, lds); }
  { FRESH_PARAMS(pb) grid_barrier(pb.ctrl, 6u); }
  { FRESH_PARAMS(p) expert_phase(p); }
}

extern "C" void kernel_launch(void* const* d_in, const int* in_sizes, int n_in, void* d_out, int out_size, void* d_ws,
                              size_t ws_size, hipStream_t stream) {
  static int grid_blocks = 0;
  if (!grid_blocks) {
    int dev = 0, cus = 0, per_cu = 0;
    (void)hipGetDevice(&dev);
    (void)hipDeviceGetAttribute(&cus, hipDeviceAttributeMultiprocessorCount, dev);
    (void)hipFuncSetAttribute((const void*)fwd_megakernel, hipFuncAttributeMaxDynamicSharedMemorySize, LDS_BYTES);
    (void)hipOccupancyMaxActiveBlocksPerMultiprocessor(&per_cu, fwd_megakernel, NTHREADS, LDS_BYTES);
    per_cu = 1;
    grid_blocks = cus * per_cu;
  }
  Params p{};
  p.x = (const float*)d_in[0]; p.c = (const float*)d_in[1]; p.pos = (const int*)d_in[2]; p.w_ada = (const float*)d_in[3];
  p.b_ada = (const float*)d_in[4]; p.g1 = (const float*)d_in[5]; p.w_in = (const float*)d_in[6]; p.conv_w = (const float*)d_in[7];
  p.qg = (const float*)d_in[8]; p.kg = (const float*)d_in[9]; p.lq1 = (const float*)d_in[10]; p.lk1 = (const float*)d_in[11];
  p.lq2 = (const float*)d_in[12]; p.lk2 = (const float*)d_in[13]; p.subg = (const float*)d_in[14]; p.w_out = (const float*)d_in[15];
  p.g2 = (const float*)d_in[16]; p.w_pq = (const float*)d_in[17]; p.keys1 = (const float*)d_in[18]; p.keys2 = (const float*)d_in[19];
  p.eu = (const float*)d_in[20]; p.ev = (const float*)d_in[21];
  p.out = (float*)d_out;
  char* w = (char*)d_ws;
  size_t off = 0;
  auto take = [&](size_t bytes) { char* r = w + off; off += (bytes + 255) & ~(size_t)255; return r; };
  p.ctrl = (unsigned*)take(4096);
  p.mod = (float*)take((size_t)NB * NADA * 4);
  p.ropec = (float*)take((size_t)NT * 32 * 4);
  p.ropes = (float*)take((size_t)NT * 32 * 4);
  p.WinT = (bf16_t*)take((size_t)INC * DM * 2);
  p.WoutT = (bf16_t*)take((size_t)DM * DM * 2);
  p.WqkT = (bf16_t*)take((size_t)DM * DM * 2);
  p.EU = (unsigned char*)take((size_t)16384 * DM);
  p.EV = (unsigned char*)take((size_t)16384 * DM);
  p.su = (float*)take(16384 * 4);
  p.sv = (float*)take(16384 * 4);
  p.hbuf = (bf16_t*)take((size_t)NT * DM * 2);
  p.mixA = (bf16_t*)take((size_t)NT * DM * 2);
  p.tidx = (int*)take((size_t)NT * 128 * 4);
  p.tg = (float*)take((size_t)NT * 128 * 4);
  char* region = take((size_t)NT * 3072 * 2 + 3 * (size_t)NT * 1024 * 2);
  p.BCH = (bf16_t*)region;
  p.Qb = (bf16_t*)(region + (size_t)NT * 3072 * 2);
  p.Kb = p.Qb + (size_t)NT * 1024;
  p.Vt = p.Kb + (size_t)NT * 1024;
  p.scores = (float*)region;
  p.x1b = p.Kb;
  if (off > ws_size) { fprintf(stderr, "workspace too small: need %zu have %zu\n", off, ws_size); return; }
  if (hipMemsetAsync(p.ctrl, 0, 4096, stream) != hipSuccess) { fprintf(stderr, "memset of the control words failed\n"); return; }
  void* args[] = {&p};
  hipError_t e = hipLaunchCooperativeKernel((void*)fwd_megakernel, dim3(grid_blocks), dim3(NTHREADS), args, LDS_BYTES, stream);
  if (e != hipSuccess) fprintf(stderr, "cooperative launch failed: %s (grid %d)\n", hipGetErrorString(e), grid_blocks);
}
```

```cpp
#include <hip/hip_runtime.h>
#include <hip/hip_cooperative_groups.h>
#include <cstdio>
#include <cstdint>
namespace cg = cooperative_groups;

#define DI __device__ __forceinline__
typedef unsigned short bf16_t;
typedef short bf16x8 __attribute__((ext_vector_type(8)));
typedef short s16x4 __attribute__((ext_vector_type(4)));
typedef float f32x16 __attribute__((ext_vector_type(16)));
typedef float f32x4 __attribute__((ext_vector_type(4)));
typedef float f32x2 __attribute__((ext_vector_type(2)));
typedef unsigned u32x4 __attribute__((ext_vector_type(4)));
typedef unsigned u32x2 __attribute__((ext_vector_type(2)));
typedef __bf16 bf2_t __attribute__((ext_vector_type(2)));

constexpr int DM = 2048, NB = 2, SEQ = 8192, NT = NB * SEQ;
constexpr int INC = 6144, NADA = 12288;
constexpr int NTHREADS = 512, NWAVES = 8;
constexpr int LDS_BYTES = 147456;

struct Params {
  const float* x; const float* c; const int* pos; const float* w_ada; const float* b_ada; const float* g1;
  const float* w_in; const float* conv_w; const float* qg; const float* kg; const float* lq1; const float* lk1;
  const float* lq2; const float* lk2; const float* subg; const float* w_out; const float* g2; const float* w_pq;
  const float* keys1; const float* keys2; const float* eu; const float* ev;
  float* out;
  unsigned* ctrl; float* mod; float* ropec; float* ropes;
  bf16_t* WinT; bf16_t* WoutT; bf16_t* WqkT; unsigned char* EU; unsigned char* EV; bf16_t* hbuf;
  float* su; float* sv;
  bf16_t* BCH; bf16_t* Qb; bf16_t* Kb; bf16_t* Vt; bf16_t* mixA;
  float* scores; int* tidx; float* tg;
  bf16_t* x1b;
};

DI unsigned pk_bf16(float lo, float hi) {
  f32x2 v = {lo, hi};
  bf2_t b = __builtin_convertvector(v, bf2_t);
  return __builtin_bit_cast(unsigned, b);
}
DI float bf_lo(unsigned u) { return __uint_as_float(u << 16); }
DI float bf_hi(unsigned u) { return __uint_as_float(u & 0xffff0000u); }
DI int crow(int i, int h) { return (i & 3) + 8 * (i >> 2) + 4 * h; }
DI int my_tid() { int t = threadIdx.x; asm volatile("" : "+v"(t)); return t; }
#define MFMA32(a, b, c) __builtin_amdgcn_mfma_f32_32x32x16_bf16((a), (b), (c), 0, 0, 0)

DI void ada_item(const Params& p, int item, float* lds) {
  const int tid = my_tid(), cgp = tid % 12, kl = tid / 12;
  const int col = item * 48 + cgp * 4;
  f32x4 a0 = {0.f, 0.f, 0.f, 0.f}, a1 = {0.f, 0.f, 0.f, 0.f};
  if (kl < 42) {
    for (int k = kl; k < DM; k += 42) {
      const f32x4 w = *(const f32x4*)(p.w_ada + (size_t)k * NADA + col);
      const float c0 = p.c[k], c1 = p.c[DM + k];
      const float s0 = c0 / (1.f + __expf(-c0)), s1 = c1 / (1.f + __expf(-c1));
      a0 += w * s0; a1 += w * s1;
    }
    float* dst = lds + (kl * 12 + cgp) * 8;
    *(f32x4*)dst = a0; *(f32x4*)(dst + 4) = a1;
  }
  __syncthreads();
  if (tid < 96) {
    const int b = tid / 48, j = tid % 48, cg2 = j >> 2, e = j & 3;
    float s = 0.f;
    for (int q = 0; q < 42; ++q) s += lds[(q * 12 + cg2) * 8 + b * 4 + e];
    p.mod[b * NADA + item * 48 + j] = s + p.b_ada[item * 48 + j];
  }
  __syncthreads();
}

DI void transpose_item(const float* __restrict__ W, bf16_t* __restrict__ Wt, int K, int N, int item2, float* lds0) {
  const int tfull = my_tid();
  const int tid = tfull & 255, item = item2 * 2 + (tfull >> 8);
  float* lds = lds0 + (tfull >> 8) * (64 * 65);
  const int ntn = N / 64;
  const int k0 = (item / ntn) * 64, n0 = (item % ntn) * 64;
  {
    const int r = tid >> 4, c4 = (tid & 15) * 4;
#pragma unroll
    for (int rr = 0; rr < 4; ++rr) {
      const int row = r + rr * 16;
      const f32x4 v = *(const f32x4*)(W + (size_t)(k0 + row) * N + n0 + c4);
      float* d = lds + row * 65 + c4;
      d[0] = v[0]; d[1] = v[1]; d[2] = v[2]; d[3] = v[3];
    }
  }
  __syncthreads();
  {
    const int n = tid >> 2, kq = (tid & 3) * 16;
    u32x4 o0, o1;
    float t[16];
#pragma unroll
    for (int j = 0; j < 16; ++j) t[j] = lds[(kq + j) * 65 + n];
    o0[0] = pk_bf16(t[0], t[1]); o0[1] = pk_bf16(t[2], t[3]); o0[2] = pk_bf16(t[4], t[5]); o0[3] = pk_bf16(t[6], t[7]);
    o1[0] = pk_bf16(t[8], t[9]); o1[1] = pk_bf16(t[10], t[11]); o1[2] = pk_bf16(t[12], t[13]); o1[3] = pk_bf16(t[14], t[15]);
    bf16_t* d = Wt + (size_t)(n0 + n) * K + k0 + kq;
    *(u32x4*)d = o0; *(u32x4*)(d + 8) = o1;
  }
  __syncthreads();
}

DI bf16x8 cvt8(const float* src) {
  const f32x4 a = *(const f32x4*)src, b = *(const f32x4*)(src + 4);
  u32x4 o; o[0] = pk_bf16(a[0], a[1]); o[1] = pk_bf16(a[2], a[3]); o[2] = pk_bf16(b[0], b[1]); o[3] = pk_bf16(b[2], b[3]);
  return __builtin_bit_cast(bf16x8, o);
}
DI void wqk_phase(const Params& p) {
  const int tid = my_tid();
  const int lane = tid & 63, r = lane & 31, h = lane >> 5;
  const int gw = __builtin_amdgcn_readfirstlane(blockIdx.x * NWAVES + (tid >> 6)), nw = gridDim.x * NWAVES;
  for (int it = gw; it < 2048; it += nw) {
    const int hh = it >> 7, mt = it & 3, kq = (it & 127) >> 2;
    const float* keys = ((hh & 1) ? p.keys2 : p.keys1) + (size_t)(mt * 32 + r) * 128 + h * 8;
    bf16x8 af[8];
#pragma unroll
    for (int ks = 0; ks < 8; ++ks) af[ks] = cvt8(keys + ks * 16);
#pragma unroll
    for (int nt = 0; nt < 2; ++nt) {
      const int krow = kq * 64 + nt * 32 + r;
      const float* wq = p.w_pq + (size_t)krow * DM + hh * 128 + h * 8;
      f32x16 acc;
#pragma unroll
      for (int i = 0; i < 16; ++i) acc[i] = 0.f;
#pragma unroll
      for (int ks = 0; ks < 8; ++ks) acc = MFMA32(af[ks], cvt8(wq + ks * 16), acc);
      bf16_t* dst = p.WqkT + (size_t)(hh * 128 + mt * 32) * DM + krow;
#pragma unroll
      for (int i = 0; i < 16; ++i) dst[(size_t)crow(i, h) * DM] = (bf16_t)(pk_bf16(acc[i], 0.f) & 0xffffu);
    }
  }
}

template <bool SRC_BF16>
DI void norm_mod_phase(const void* __restrict__ srcv, const float* __restrict__ g, const float* __restrict__ mod,
                       int which_shift, bf16_t* __restrict__ dst) {
  const int tid = my_tid();
  const int lane = tid & 63;
  const int gw = __builtin_amdgcn_readfirstlane(blockIdx.x * NWAVES + (tid >> 6)), nw = gridDim.x * NWAVES;
  f32x4 ga[8], sh[8];
  int cur_b = -1;
  for (int tok = gw; tok < NT; tok += nw) {
    const int b = tok >> 13;
    if (b != cur_b) {
      cur_b = b;
      const float* mb = mod + b * NADA + which_shift * DM;
#pragma unroll
      for (int j = 0; j < 8; ++j) {
        const int col = (j * 64 + lane) * 4;
        const f32x4 gg = *(const f32x4*)(g + col);
        const f32x4 sc = *(const f32x4*)(mb + DM + col);
        sh[j] = *(const f32x4*)(mb + col);
#pragma unroll
        for (int e = 0; e < 4; ++e) ga[j][e] = gg[e] * (1.f + sc[e]);
      }
    }
    f32x4 v[8];
    float ss = 0.f;
#pragma unroll
    for (int j = 0; j < 8; ++j) {
      if (SRC_BF16) {
        const u32x2 w = *(const u32x2*)((const bf16_t*)srcv + (size_t)tok * DM + (j * 64 + lane) * 4);
        v[j][0] = bf_lo(w[0]); v[j][1] = bf_hi(w[0]); v[j][2] = bf_lo(w[1]); v[j][3] = bf_hi(w[1]);
      } else {
        v[j] = *(const f32x4*)((const float*)srcv + (size_t)tok * DM + (j * 64 + lane) * 4);
      }
      ss += v[j][0] * v[j][0] + v[j][1] * v[j][1] + v[j][2] * v[j][2] + v[j][3] * v[j][3];
    }
#pragma unroll
    for (int m = 1; m < 64; m <<= 1) ss += __shfl_xor(ss, m);
    const float inv = rsqrtf(ss * (1.f / DM) + 1e-6f);
#pragma unroll
    for (int j = 0; j < 8; ++j) {
      const int col = (j * 64 + lane) * 4;
      f32x4 y;
#pragma unroll
      for (int e = 0; e < 4; ++e) y[e] = (v[j][e] * inv) * ga[j][e] + sh[j][e];
      u32x2 o; o[0] = pk_bf16(y[0], y[1]); o[1] = pk_bf16(y[2], y[3]);
      *(u32x2*)(dst + (size_t)tok * DM + col) = o;
    }
  }
}

DI unsigned fmap(float f) { const unsigned u = __float_as_uint(f); return u ^ ((u >> 31) ? 0xffffffffu : 0x80000000u); }
DI float funmap(unsigned u) { return __uint_as_float(u ^ ((u >> 31) ? 0x80000000u : 0xffffffffu)); }
#define INSERT16(list, key) { unsigned _k = (key); _Pragma("unroll") for (int _j = 0; _j < 16; ++_j) { const unsigned _hi = max(list[_j], _k); _k = min(list[_j], _k); list[_j] = _hi; } }

template <bool DESC>
DI void bitonic_sort16(unsigned (&a)[16]) {
#pragma unroll
  for (int k = 2; k <= 16; k <<= 1) {
#pragma unroll
    for (int j = k >> 1; j > 0; j >>= 1) {
#pragma unroll
      for (int i = 0; i < 16; ++i) {
        const int l = i ^ j;
        if (l > i) {
          const bool up = (((i & k) == 0) == DESC);
          const unsigned hi = max(a[i], a[l]), lo = min(a[i], a[l]);
          a[i] = up ? hi : lo; a[l] = up ? lo : hi;
        }
      }
    }
  }
}
DI void merge_top16(unsigned (&L)[16], const unsigned (&G)[16]) {
#pragma unroll
  for (int i = 0; i < 16; ++i) L[i] = max(L[i], G[i]);
#pragma unroll
  for (int j = 8; j > 0; j >>= 1) {
#pragma unroll
    for (int i = 0; i < 16; ++i) {
      const int l = i ^ j;
      if (l > i) { const unsigned hi = max(L[i], L[l]), lo = min(L[i], L[l]); L[i] = hi; L[l] = lo; }
    }
  }
}

constexpr int CAND_I[64] = {0, 0, 0, 0, 0, 0, 0, 0, 0, 0, 0, 0, 0, 0, 0, 0, 1, 1, 1, 1, 1, 1, 1, 1, 2, 2, 2, 2, 2, 3, 3, 3, 3, 4, 4, 4, 5, 5, 6, 6, 7, 7, 8, 9, 10, 11, 12, 13, 14, 15, 0, 0, 0, 0, 0, 0, 0, 0, 0, 0, 0, 0, 0, 0};
constexpr int CAND_J[64] = {0, 1, 2, 3, 4, 5, 6, 7, 8, 9, 10, 11, 12, 13, 14, 15, 0, 1, 2, 3, 4, 5, 6, 7, 0, 1, 2, 3, 4, 0, 1, 2, 3, 0, 1, 2, 0, 1, 0, 1, 0, 1, 0, 0, 0, 0, 0, 0, 0, 0, 0, 0, 0, 0, 0, 0, 0, 0, 0, 0, 0, 0, 0, 0};

DI void topk_merge4(const u32x4* pl, unsigned (&list)[16]) {
#pragma unroll
  for (int q = 0; q < 4; ++q) { const u32x4 v = pl[q]; list[4 * q] = v[0]; list[4 * q + 1] = v[1]; list[4 * q + 2] = v[2]; list[4 * q + 3] = v[3]; }
#pragma unroll
  for (int part = 1; part < 4; ++part) {
    unsigned g[16];
#pragma unroll
    for (int q = 0; q < 4; ++q) { const u32x4 v = pl[part * 4 + q]; g[15 - 4 * q] = v[0]; g[14 - 4 * q] = v[1]; g[13 - 4 * q] = v[2]; g[12 - 4 * q] = v[3]; }
    merge_top16(list, g);
  }
}
DI void topk_finish(const Params& p, unsigned (&list)[16], int tok, int hh, unsigned* my) {
  {
    unsigned other[16];
#pragma unroll
    for (int j = 0; j < 16; ++j) other[j] = (unsigned)__shfl_xor((int)list[j], 1);
    const bool first = (hh & 1) == 0;
    unsigned A[16], B[16];
#pragma unroll
    for (int j = 0; j < 16; ++j) { A[j] = first ? list[j] : other[j]; B[j] = first ? other[j] : list[j]; }
#pragma unroll
    for (int w = 0; w < 4; ++w) {
      my[w] = (A[4 * w] & 127u) | ((A[4 * w + 1] & 127u) << 8) | ((A[4 * w + 2] & 127u) << 16) | ((A[4 * w + 3] & 127u) << 24);
      my[4 + w] = (B[4 * w] & 127u) | ((B[4 * w + 1] & 127u) << 8) | ((B[4 * w + 2] & 127u) << 16) | ((B[4 * w + 3] & 127u) << 24);
    }
    float va[16], vb[16];
#pragma unroll
    for (int j = 0; j < 16; ++j) { va[j] = funmap(A[j] & ~127u); vb[j] = funmap(B[j] & ~127u); }
    unsigned top[16];
#pragma unroll
    for (int grp = 0; grp < 4; ++grp) {
      unsigned g[16];
#pragma unroll
      for (int t = 0; t < 16; ++t) {
        const int c = grp * 16 + t;
        g[t] = (c < 50) ? ((fmap(va[CAND_I[c]] + vb[CAND_J[c]]) & ~255u) | (unsigned)(CAND_I[c] * 16 + CAND_J[c])) : 0u;
      }
      if (grp == 0) {
        bitonic_sort16<true>(g);
#pragma unroll
        for (int j = 0; j < 16; ++j) top[j] = g[j];
      } else {
        bitonic_sort16<false>(g);
        merge_top16(top, g);
      }
    }
    float ev[16], sum = 0.f;
    const float mx = funmap(top[0] & ~255u);
#pragma unroll
    for (int j = 0; j < 16; ++j) { ev[j] = __expf(funmap(top[j] & ~255u) - mx); sum += ev[j]; }
    const float rs = 1.f / sum;
    const int head = hh >> 1;
    if (first) {
      int* dst = p.tidx + ((size_t)tok * 8 + head) * 16;
#pragma unroll
      for (int j = 0; j < 16; ++j) {
        const unsigned code = top[j] & 255u, ci = code >> 4, cj = code & 15u;
        const unsigned i1 = (my[ci >> 2] >> ((ci & 3u) * 8)) & 255u;
        const unsigned i2 = (my[4 + (cj >> 2)] >> ((cj & 3u) * 8)) & 255u;
        dst[j] = (int)(i1 * 128u + i2);
      }
    } else {
      float* dst = p.tg + ((size_t)tok * 8 + head) * 16;
#pragma unroll
      for (int j = 0; j < 16; ++j) dst[j] = ev[j] * rs;
    }
  }
}

template <int EPI>
DI void gemm_epilogue(const Params& p, const f32x16 (&acc)[4][2], int m_base, int tn, int wc, int r, int h) {
  const int n_base = tn * 128 + wc * 64;
  if (EPI == 1) {
    const int grp = tn >> 3;
    if (grp < 3) {
#pragma unroll
      for (int mt = 0; mt < 4; ++mt) {
        const int m = m_base + mt * 32 + r;
#pragma unroll
        for (int nt = 0; nt < 2; ++nt)
#pragma unroll
          for (int g = 0; g < 4; ++g) {
            const int n = n_base + nt * 32 + 8 * g + 4 * h;
            u32x2 o; o[0] = pk_bf16(acc[mt][nt][4 * g], acc[mt][nt][4 * g + 1]); o[1] = pk_bf16(acc[mt][nt][4 * g + 2], acc[mt][nt][4 * g + 3]);
            *(u32x2*)(p.BCH + (size_t)m * 3072 + n) = o;
          }
      }
    } else if (grp == 5) {
      const int head = tn - 40;
#pragma unroll
      for (int mt = 0; mt < 4; ++mt) {
        const int m = m_base + mt * 32 + r;
        const int b = m >> 13, s = m & 8191;
#pragma unroll
        for (int nt = 0; nt < 2; ++nt)
#pragma unroll
          for (int i = 0; i < 16; ++i) {
            const int e = wc * 64 + nt * 32 + crow(i, h);
            p.Vt[((size_t)(((b * 8 + head) * 128 + (s >> 6)) * 128 + e)) * 64 + (s & 63)] = (bf16_t)(pk_bf16(acc[mt][nt][i], 0.f) & 0xffffu);
          }
      }
    } else {
      const bool isq = (grp == 3);
      const int head = tn - (isq ? 24 : 32);
      const int half = wc;
      const float* gn = isq ? p.qg : p.kg;
      const float osc = isq ? (0.125f * 1.4426950408889634f) : 1.f;
      bf16_t* dbase = isq ? p.Qb : p.Kb;
#pragma unroll
      for (int mt = 0; mt < 4; ++mt) {
        const int m = m_base + mt * 32 + r;
        const int b = m >> 13, s = m & 8191;
        float ss = 0.f;
#pragma unroll
        for (int nt = 0; nt < 2; ++nt)
#pragma unroll
          for (int i = 0; i < 16; ++i) ss += acc[mt][nt][i] * acc[mt][nt][i];
        ss += __shfl_xor(ss, 32);
        const float inv = rsqrtf(ss * (1.f / 64.f) + 1e-6f);
        bf16_t* dst = dbase + ((size_t)(((b * 8 + head) * 2 + half)) * SEQ + s) * 64;
#pragma unroll
        for (int g = 0; g < 4; ++g) {
          const int d0 = 8 * g + 4 * h;
          const f32x4 cs = *(const f32x4*)(p.ropec + (size_t)m * 32 + d0);
          const f32x4 sn = *(const f32x4*)(p.ropes + (size_t)m * 32 + d0);
          const f32x4 ga = *(const f32x4*)(gn + d0);
          const f32x4 gb = *(const f32x4*)(gn + 32 + d0);
          float o0[4], o1[4];
#pragma unroll
          for (int j = 0; j < 4; ++j) {
            const float y0 = acc[mt][0][4 * g + j] * inv * ga[j];
            const float y1 = acc[mt][1][4 * g + j] * inv * gb[j];
            o0[j] = (y0 * cs[j] - y1 * sn[j]) * osc;
            o1[j] = (y1 * cs[j] + y0 * sn[j]) * osc;
          }
          u32x2 a; a[0] = pk_bf16(o0[0], o0[1]); a[1] = pk_bf16(o0[2], o0[3]);
          u32x2 bq; bq[0] = pk_bf16(o1[0], o1[1]); bq[1] = pk_bf16(o1[2], o1[3]);
          *(u32x2*)(dst + d0) = a;
          *(u32x2*)(dst + 32 + d0) = bq;
        }
      }
    }
  } else if (EPI == 2) {
#pragma unroll
    for (int mt = 0; mt < 4; ++mt) {
      const int m = m_base + mt * 32 + r;
      const int b = m >> 13;
      const float* gate = p.mod + b * NADA + 2 * DM;
#pragma unroll
      for (int nt = 0; nt < 2; ++nt)
#pragma unroll
        for (int g = 0; g < 4; ++g) {
          const int n = n_base + nt * 32 + 8 * g + 4 * h;
          const f32x4 xv = *(const f32x4*)(p.x + (size_t)m * DM + n);
          const f32x4 gt = *(const f32x4*)(gate + n);
          f32x4 o;
#pragma unroll
          for (int j = 0; j < 4; ++j) o[j] = xv[j] + gt[j] * acc[mt][nt][4 * g + j];
          u32x2 ob; ob[0] = pk_bf16(o[0], o[1]); ob[1] = pk_bf16(o[2], o[3]);
          *(u32x2*)(p.x1b + (size_t)m * DM + n) = ob;
        }
    }
  } else {
    unsigned* plist = (unsigned*)p.scores;
#pragma unroll
    for (int mt = 0; mt < 4; ++mt) {
      const int m = m_base + mt * 32 + r;
      unsigned a[16], b[16];
#pragma unroll
      for (int i = 0; i < 16; ++i) {
        a[i] = (fmap(acc[mt][0][i]) & ~127u) | (unsigned)(wc * 64 + crow(i, h));
        b[i] = (fmap(acc[mt][1][i]) & ~127u) | (unsigned)(wc * 64 + 32 + crow(i, h));
      }
      bitonic_sort16<true>(a);
      bitonic_sort16<false>(b);
      merge_top16(a, b);
      unsigned* dst = plist + (((size_t)m * 16 + tn) * 4 + (wc * 2 + h)) * 16;
#pragma unroll
      for (int q = 0; q < 4; ++q) { u32x4 o; o[0] = a[4 * q]; o[1] = a[4 * q + 1]; o[2] = a[4 * q + 2]; o[3] = a[4 * q + 3]; *(u32x4*)(dst + 4 * q) = o; }
    }
  }
}

template <int EPI>
DI void gemm_phase(const Params& p, const bf16_t* __restrict__ A, const bf16_t* __restrict__ Bt, int N, char* lds) {
  constexpr int K = DM;
  const int tid = my_tid(), lane = tid & 63, wave = tid >> 6, wr = wave >> 2, wc = wave & 3;
  const int r = lane & 31, h = lane >> 5;
  const int nNt = N / 256;
  const int stM = (NT / 256) / 8, stN = nNt / 4, nST = stM * stN;
  const int G = gridDim.x;
  const int xcd = blockIdx.x & 7, local = blockIdx.x >> 3;
  const int nb = (G - xcd + 7) >> 3;
  const int cnt = (nST - xcd + 7) >> 3;
  const int srow = tid >> 3, sc = tid & 7;
  for (int e = local; e < cnt * 32; e += nb) {
    const int st = xcd + 8 * (e >> 5), w = e & 31;
    const int stm = st % stM, stn = st / stM;
    const int tm = stm * 8 + (w & 7), tn = stn * 4 + (w >> 3);
    f32x16 acc[4][2];
#pragma unroll
    for (int a = 0; a < 4; ++a)
#pragma unroll
      for (int b = 0; b < 2; ++b)
#pragma unroll
        for (int i = 0; i < 16; ++i) acc[a][b][i] = 0.f;
    const bf16_t* Ag = A + (size_t)(tm * 256 + srow) * K + ((sc ^ ((srow >> 1) & 7)) * 8);
    const bf16_t* Bg = Bt + (size_t)(tn * 256 + srow) * K + ((sc ^ ((srow >> 1) & 7)) * 8);
#define GLDS(BUF, KT) _Pragma("unroll") for (int i = 0; i < 4; ++i) { \
      __builtin_amdgcn_global_load_lds((const unsigned*)(Ag + (size_t)i * 64 * K + (KT) * 64), (unsigned*)(lds + (BUF) * 65536 + tid * 16 + i * 8192), 16, 0, 0); \
      __builtin_amdgcn_global_load_lds((const unsigned*)(Bg + (size_t)i * 64 * K + (KT) * 64), (unsigned*)(lds + (BUF) * 65536 + 32768 + tid * 16 + i * 8192), 16, 0, 0); }
    GLDS(0, 0)
    __syncthreads();
#pragma unroll 1
    for (int kt = 0; kt < K / 64; ++kt) {
      const int cur = kt & 1;
      if (kt + 1 < K / 64) { GLDS(cur ^ 1, kt + 1) }
      const char* sA = lds + cur * 65536;
      const char* sB = sA + 32768;
#pragma unroll
      for (int ks = 0; ks < 4; ++ks) {
        const int coff = ((ks * 2 + h) ^ ((r >> 1) & 7)) << 4;
        bf16x8 af[4], bfr[2];
#pragma unroll
        for (int mt = 0; mt < 4; ++mt) af[mt] = *(const bf16x8*)(sA + (wr * 128 + mt * 32 + r) * 128 + coff);
#pragma unroll
        for (int nt = 0; nt < 2; ++nt) bfr[nt] = *(const bf16x8*)(sB + (wc * 64 + nt * 32 + r) * 128 + coff);
#pragma unroll
        for (int mt = 0; mt < 4; ++mt)
#pragma unroll
          for (int nt = 0; nt < 2; ++nt) acc[mt][nt] = MFMA32(bfr[nt], af[mt], acc[mt][nt]);
      }
      __syncthreads();
    }
#undef GLDS
    if (EPI != 3) {
      gemm_epilogue<EPI>(p, acc, tm * 256 + wr * 128, tn * 2 + (wc >> 1), wc & 1, r, h);
    } else {
#pragma unroll
      for (int mt = 0; mt < 4; ++mt) {
        const int row = wr * 128 + mt * 32 + r;
        unsigned a[16], b[16];
#pragma unroll
        for (int i = 0; i < 16; ++i) {
          a[i] = (fmap(acc[mt][0][i]) & ~127u) | (unsigned)((wc & 1) * 64 + crow(i, h));
          b[i] = (fmap(acc[mt][1][i]) & ~127u) | (unsigned)((wc & 1) * 64 + 32 + crow(i, h));
        }
        bitonic_sort16<true>(a);
        bitonic_sort16<false>(b);
        merge_top16(a, b);
        unsigned* dst = (unsigned*)lds + (((row * 2 + (wc >> 1)) * 4 + ((wc & 1) * 2 + h)) * 16);
#pragma unroll
        for (int q = 0; q < 4; ++q) { u32x4 o; o[0] = a[4 * q]; o[1] = a[4 * q + 1]; o[2] = a[4 * q + 2]; o[3] = a[4 * q + 3]; *(u32x4*)(dst + 4 * q) = o; }
      }
      __syncthreads();
      {
        unsigned list[16];
        topk_merge4((const u32x4*)((const unsigned*)lds + tid * 64), list);
        topk_finish(p, list, tm * 256 + (tid >> 1), tn * 2 + (tid & 1), (unsigned*)(lds + 131072) + tid * 8);
      }
      __syncthreads();
    }
  }
}

typedef float v16f_t __attribute__((ext_vector_type(16)));
typedef float v32f_t __attribute__((ext_vector_type(32)));
typedef _Float16 v32h_t __attribute__((ext_vector_type(32)));
typedef unsigned v6u_t __attribute__((ext_vector_type(6)));
constexpr unsigned EROW = 1536u;
DI void fp6_rows_phase(const Params& p) {
  const int tid = my_tid();
  const int lane = tid & 63;
  const int gw = __builtin_amdgcn_readfirstlane(blockIdx.x * NWAVES + (tid >> 6)), nw = gridDim.x * NWAVES;
  for (int row = gw; row < 32768; row += nw) {
    const bool second = row >= 16384;
    const int r = row & 16383;
    const float* src = (second ? p.ev : p.eu) + (size_t)r * DM;
    f32x4 v[8];
    float mx = 0.f;
#pragma unroll
    for (int j = 0; j < 8; ++j) {
      v[j] = *(const f32x4*)(src + (unsigned)((j * 64 + lane) * 4));
      mx = fmaxf(mx, fmaxf(fmaxf(fabsf(v[j][0]), fabsf(v[j][1])), fmaxf(fabsf(v[j][2]), fabsf(v[j][3]))));
    }
#pragma unroll
    for (int m = 1; m < 64; m <<= 1) mx = fmaxf(mx, __shfl_xor(mx, m));
    const float sc = mx > 0.f ? 7.0f / mx : 1.f;
    const float inv = mx > 0.f ? mx * (1.f / 7.0f) : 1.f;
    v32h_t a;
#pragma unroll
    for (int j = 0; j < 8; ++j)
#pragma unroll
      for (int e = 0; e < 4; ++e) a[j * 4 + e] = (_Float16)(v[j][e] * sc);
    const v6u_t pk = __builtin_amdgcn_cvt_scalef32_pk32_fp6_f16(a, 1.0f);
    unsigned char* dst = (second ? p.EV : p.EU) + (size_t)r * EROW;
    u32x4 w0; w0[0] = pk[0]; w0[1] = pk[1]; w0[2] = pk[2]; w0[3] = pk[3];
    u32x2 w1; w1[0] = pk[4]; w1[1] = pk[5];
    *(u32x4*)(dst + (unsigned)lane * 16u) = w0;
    *(u32x2*)(dst + 1024u + (unsigned)lane * 8u) = w1;
    if (lane == 0) (second ? p.sv : p.su)[r] = inv;
  }
}

DI void conv_phase(const Params& p) {
  const int tid = my_tid();
  const int ch = (tid & 127) * 8, tsub = tid >> 7;
  float w0[8], w1[8], w2[8];
#pragma unroll
  for (int j = 0; j < 8; ++j) { w0[j] = p.conv_w[ch + j]; w1[j] = p.conv_w[1024 + ch + j]; w2[j] = p.conv_w[2048 + ch + j]; }
  for (int unit = blockIdx.x; unit < NT / 64; unit += gridDim.x) {
    const int t0 = unit * 64 + tsub * 16;
    float z1[8], z2[8];
#pragma unroll
    for (int j = 0; j < 8; ++j) { z1[j] = 0.f; z2[j] = 0.f; }
    const int s0 = t0 & 8191;
    for (int back = 2; back >= 1; --back) {
      if (s0 - back >= 0) {
        const bf16_t* rowp = p.BCH + (size_t)(t0 - back) * 3072;
        const u32x4 cv = *(const u32x4*)(rowp + 1024 + ch);
        const u32x4 hv = *(const u32x4*)(rowp + 2048 + ch);
#pragma unroll
        for (int q = 0; q < 4; ++q) {
          const float a = bf_lo(cv[q]) * bf_lo(hv[q]), b = bf_hi(cv[q]) * bf_hi(hv[q]);
          if (back == 2) { z2[2 * q] = a; z2[2 * q + 1] = b; } else { z1[2 * q] = a; z1[2 * q + 1] = b; }
        }
      }
    }
    for (int tt = 0; tt < 16; ++tt) {
      const int t = t0 + tt;
      const bf16_t* rowp = p.BCH + (size_t)t * 3072;
      const u32x4 bv = *(const u32x4*)(rowp + ch);
      const u32x4 cv = *(const u32x4*)(rowp + 1024 + ch);
      const u32x4 hv = *(const u32x4*)(rowp + 2048 + ch);
      float z0[8], y[8];
#pragma unroll
      for (int q = 0; q < 4; ++q) {
        z0[2 * q] = bf_lo(cv[q]) * bf_lo(hv[q]); z0[2 * q + 1] = bf_hi(cv[q]) * bf_hi(hv[q]);
      }
#pragma unroll
      for (int q = 0; q < 4; ++q) {
        y[2 * q] = bf_lo(bv[q]) * (w0[2 * q] * z2[2 * q] + w1[2 * q] * z1[2 * q] + w2[2 * q] * z0[2 * q]);
        y[2 * q + 1] = bf_hi(bv[q]) * (w0[2 * q + 1] * z2[2 * q + 1] + w1[2 * q + 1] * z1[2 * q + 1] + w2[2 * q + 1] * z0[2 * q + 1]);
      }
      u32x4 o;
#pragma unroll
      for (int q = 0; q < 4; ++q) o[q] = pk_bf16(y[2 * q], y[2 * q + 1]);
      *(u32x4*)(p.mixA + (size_t)t * DM + ch) = o;
#pragma unroll
      for (int j = 0; j < 8; ++j) { z2[j] = z1[j]; z1[j] = z0[j]; }
    }
  }
}

DI void attn_phase(const Params& p, char* lds, int* s_item, float* s_lam) {
  const int tid = my_tid(), lane = tid & 63, wave = tid >> 6;
  const int r = lane & 31, h = lane >> 5;
  float d1 = 0.f, d2 = 0.f, mq = 0.f, mk = 0.f;
  for (int i = 0; i < 64; ++i) {
    d1 += p.lq1[i] * p.lk1[i]; d2 += p.lq2[i] * p.lk2[i];
    mq = fmaxf(mq, fabsf(p.qg[i])); mk = fmaxf(mk, fabsf(p.kg[i]));
  }
  const float lam_init = 0.2f;
  const float negM2 = -(8.f * mq * mk * 1.4426950408889634f * 1.02f + 0.25f);
  if (tid == 0) s_lam[0] = __expf(d1) - __expf(d2) + lam_init;
  char* Qs = lds;
  char* Ks = lds + 73728;
  char* Vs = lds + 92160;
  int n_items = 0;
  bool did_conv = false;
  while (true) {
    if (tid == 0) *s_item = (int)atomicAdd(&p.ctrl[1], 1u);
    __syncthreads();
    const int item = __builtin_amdgcn_readfirstlane(*s_item);
    __syncthreads();
    if (item >= 512) break;
    ++n_items;
    const int qi = 31 - (item >> 4), bh = item & 15;
    const int q0 = qi * 256;
    unsigned thr = (unsigned)((tid >> 3) * 128 + (tid & 7) * 16);
    asm volatile("" : "+v"(thr));
    const char* Qg = (const char*)p.Qb + (size_t)(bh * 2) * SEQ * 128;
    const char* Kg = (const char*)p.Kb + (size_t)(bh * 2) * SEQ * 128;
    const char* Vg = (const char*)p.Vt + (size_t)bh * 128 * SEQ * 2;
    {
      int t2 = tid; asm volatile("" : "+v"(t2));
      char* qst = Qs + (t2 >> 3) * 144 + (t2 & 7) * 16;
#pragma unroll
      for (int i = 0; i < 8; ++i) {
        const u32x4 v = *(const u32x4*)(Qg + ((size_t)(i >> 2) * SEQ + q0 + (i & 3) * 64) * 128 + thr);
        *(u32x4*)(qst + (i >> 2) * 36864 + (i & 3) * 64 * 144) = v;
      }
    }
    const int nkt = 4 * qi + 4;
    u32x4 rk[2], rv[2];
    auto prefetch = [&](int kt) {
      const char* kb = Kg + (size_t)kt * 64 * 128;
      const char* vb = Vg + (size_t)kt * 16384;
#pragma unroll
      for (int i = 0; i < 2; ++i) {
        rk[i] = *(const u32x4*)(kb + ((size_t)i * SEQ) * 128 + thr);
        rv[i] = *(const u32x4*)(vb + i * 64 * 128 + thr);
      }
    };
    prefetch(0);
    f32x16 O0[4], O1[4];
#pragma unroll
    for (int et = 0; et < 4; ++et)
#pragma unroll
      for (int i = 0; i < 16; ++i) { O0[et][i] = 0.f; O1[et][i] = 0.f; }
    float l0 = 0.f, l1 = 0.f;
    const int qglob = q0 + wave * 32 + r;
    char* kst = Ks + (tid >> 3) * 144 + (tid & 7) * 16;
    char* vst = Vs + (tid >> 3) * 144 + ((tid & 7) >> 1) * 32 + (tid & 1) * 8;
    const char* kfr0 = Ks + r * 144 + h * 16;
    const char* qfr = Qs + (wave * 32 + r) * 144 + h * 16;
    const char* vfr0 = Vs + r * 144 + h * 16;
#define KV_STORE(BUF) _Pragma("unroll") for (int i = 0; i < 2; ++i) { \
        *(u32x4*)(kst + (BUF) * 36864 + i * 9216) = rk[i]; \
        u32x2 lo, hi; lo[0] = rv[i][0]; lo[1] = rv[i][1]; hi[0] = rv[i][2]; hi[1] = rv[i][3]; \
        *(u32x2*)(vst + (BUF) * 36864 + i * 64 * 144) = lo; \
        *(u32x2*)(vst + (BUF) * 36864 + i * 64 * 144 + 16) = hi; }
    KV_STORE(0)
    if (nkt > 1) prefetch(1);
    __syncthreads();
#pragma unroll 1
    for (int kt = 0; kt < nkt; ++kt) {
      const int cur = kt & 1;
      const char* kfr = kfr0 + cur * 36864;
      const char* vfr = vfr0 + cur * 36864;
      const int key0 = kt * 64;
      const bool diag = (kt >= 4 * qi);
#pragma unroll
      for (int kk = 0; kk < 2; ++kk) {
        const int kbase = key0 + kk * 32;
        if (kbase > q0 + wave * 32 + 31) continue;
        bf16x8 P0[2], P1[2];
        bf16x8 vf[4];
#pragma unroll
        for (int hf = 0; hf < 2; ++hf) {
          bf16x8 kf[4], qf[4];
#pragma unroll
          for (int ks = 0; ks < 4; ++ks) {
            kf[ks] = *(const bf16x8*)(kfr + hf * 9216 + kk * 32 * 144 + ks * 32);
            qf[ks] = *(const bf16x8*)(qfr + hf * 36864 + ks * 32);
          }
          __builtin_amdgcn_sched_barrier(0);
          f32x16 X;
#pragma unroll
          for (int i = 0; i < 16; ++i) X[i] = negM2;
#pragma unroll
          for (int ks = 0; ks < 4; ++ks) X = MFMA32(kf[ks], qf[ks], X);
          if (hf == 1) {
#pragma unroll
            for (int et = 0; et < 2; ++et)
#pragma unroll
              for (int s = 0; s < 2; ++s) vf[et * 2 + s] = *(const bf16x8*)(vfr + et * 32 * 144 + (kk * 2 + s) * 32);
          }
          __builtin_amdgcn_sched_barrier(0);
          float ls = 0.f;
#pragma unroll
          for (int i = 0; i < 16; ++i) {
            float e0 = __builtin_amdgcn_exp2f(X[i]);
            if (diag) e0 = ((kbase + crow(i, h)) <= qglob) ? e0 : 0.f;
            X[i] = e0; ls += e0;
          }
#pragma unroll
          for (int s = 0; s < 2; ++s) {
            u32x4 a;
#pragma unroll
            for (int j = 0; j < 4; ++j) a[j] = pk_bf16(X[8 * s + 2 * j], X[8 * s + 2 * j + 1]);
            if (hf == 0) P0[s] = __builtin_bit_cast(bf16x8, a); else P1[s] = __builtin_bit_cast(bf16x8, a);
          }
          if (hf == 0) l0 += ls; else l1 += ls;
          __builtin_amdgcn_sched_barrier(0);
        }
        bf16x8 vg[4];
#pragma unroll
        for (int et = 2; et < 4; ++et)
#pragma unroll
          for (int s = 0; s < 2; ++s) vg[(et - 2) * 2 + s] = *(const bf16x8*)(vfr + et * 32 * 144 + (kk * 2 + s) * 32);
        __builtin_amdgcn_sched_barrier(0);
#pragma unroll
        for (int et = 0; et < 2; ++et) {
#pragma unroll
          for (int s = 0; s < 2; ++s) {
            O0[et] = MFMA32(vf[et * 2 + s], P0[s], O0[et]);
            O1[et] = MFMA32(vf[et * 2 + s], P1[s], O1[et]);
          }
        }
        __builtin_amdgcn_sched_barrier(0);
#pragma unroll
        for (int et = 2; et < 4; ++et) {
#pragma unroll
          for (int s = 0; s < 2; ++s) {
            O0[et] = MFMA32(vg[(et - 2) * 2 + s], P0[s], O0[et]);
            O1[et] = MFMA32(vg[(et - 2) * 2 + s], P1[s], O1[et]);
          }
        }
        __builtin_amdgcn_sched_barrier(0);
      }
      if (kt + 1 < nkt) {
        if (cur == 0) { KV_STORE(1) } else { KV_STORE(0) }
        if (kt + 2 < nkt) prefetch(kt + 2);
      }
      __syncthreads();
    }
#undef KV_STORE
    l0 += __shfl_xor(l0, 32); l1 += __shfl_xor(l1, 32);
    const float i0 = 1.f / l0, i1 = s_lam[0] / l1;
    float ss = 0.f;
#pragma unroll
    for (int et = 0; et < 4; ++et)
#pragma unroll
      for (int i = 0; i < 16; ++i) { const float o = O0[et][i] * i0 - O1[et][i] * i1; O0[et][i] = o; ss += o * o; }
    ss += __shfl_xor(ss, 32);
    const float rinv = rsqrtf(ss * (1.f / 128.f) + 1e-5f) * (1.f - lam_init);
    const int t = (bh >> 3) * SEQ + qglob;
    bf16_t* dst = p.mixA + (size_t)t * DM + 1024 + (bh & 7) * 128;
#pragma unroll
    for (int et = 0; et < 4; ++et)
#pragma unroll
      for (int g = 0; g < 4; ++g) {
        const int e = et * 32 + 8 * g + 4 * h;
        const f32x4 sg = *(const f32x4*)(p.subg + e);
        u32x2 o;
        o[0] = pk_bf16(O0[et][4 * g] * rinv * sg[0], O0[et][4 * g + 1] * rinv * sg[1]);
        o[1] = pk_bf16(O0[et][4 * g + 2] * rinv * sg[2], O0[et][4 * g + 3] * rinv * sg[3]);
        *(u32x2*)(dst + e) = o;
      }
    if (!did_conv) { did_conv = true; conv_phase(p); fp6_rows_phase(p); }
  }
  if (!did_conv) { conv_phase(p); fp6_rows_phase(p); }
}

constexpr int bitrev4(int j) { return ((j & 1) << 3) | ((j & 2) << 1) | ((j & 4) >> 1) | ((j & 8) >> 3); }
DI void expert_phase(const Params& p) {
  const int tid = my_tid();
  const int lane = tid & 63;
  const int gw = __builtin_amdgcn_readfirstlane(blockIdx.x * NWAVES + (tid >> 6)), nw = gridDim.x * NWAVES;
  const int b0 = lane & 1, b1 = (lane >> 1) & 1, b2 = (lane >> 2) & 1, b3 = (lane >> 3) & 1;
  const int mypick = b0 * 8 + b1 * 4 + b2 * 2 + b3;
  const unsigned loff16 = (unsigned)lane * 16u, loff8 = 1024u + (unsigned)lane * 8u;
  for (int tok = gw; tok < NT; tok += nw) {
    unsigned ln = (unsigned)lane;
    asm volatile("" : "+v"(ln));
    f32x2 hf[16];
#pragma unroll
    for (int j = 0; j < 8; ++j) {
      const u32x2 w = *(const u32x2*)((const char*)(p.hbuf + (size_t)tok * DM) + (ln * 8u + (unsigned)(j * 512)));
      f32x2 t0 = {bf_lo(w[0]), bf_hi(w[0])}, t1 = {bf_lo(w[1]), bf_hi(w[1])};
      hf[2 * j] = t0; hf[2 * j + 1] = t1;
    }
    const int* tip = p.tidx + (size_t)tok * 128;
    const float* tgp = p.tg + (size_t)tok * 128;
    const int il = tip[ln], ih = tip[64u + ln];
    const float gl = tgp[ln], gh = tgp[64u + ln];
    f32x2 out[16];
#pragma unroll
    for (int k = 0; k < 16; ++k) { f32x2 z = {0.f, 0.f}; out[k] = z; }
#pragma unroll 1
    for (int head = 0; head < 8; ++head) {
      const int isel = head < 4 ? il : ih;
      const float gsel = head < 4 ? gl : gh;
      const int lbase = (head & 3) * 16;
      const int emy = __shfl(isel, lbase + mypick);
      const float suv = p.su[emy], svv = p.sv[emy];
      float part[16];
#pragma unroll
      for (int j = 0; j < 16; ++j) {
        const int e = __builtin_amdgcn_readlane(isel, lbase + j);
        const char* urow = (const char*)p.EU + (size_t)(unsigned)e * EROW;
        const u32x4 w0 = *(const u32x4*)(urow + loff16);
        const u32x2 w1 = *(const u32x2*)(urow + loff8);
        v6u_t pk; pk[0] = w0[0]; pk[1] = w0[1]; pk[2] = w0[2]; pk[3] = w0[3]; pk[4] = w1[0]; pk[5] = w1[1];
        const v32f_t u = __builtin_amdgcn_cvt_scalef32_pk32_f32_fp6(pk, 1.0f);
        f32x2 acc = {0.f, 0.f};
#pragma unroll
        for (int q = 0; q < 16; ++q) { f32x2 t = {u[2 * q], u[2 * q + 1]}; acc = t * hf[q] + acc; }
        part[j] = acc.x + acc.y;
        if ((j & 3) == 3) __builtin_amdgcn_sched_barrier(0);
      }
#pragma unroll
      for (int j = 0; j < 8; ++j) {
        const float send = b0 ? part[j] : part[j + 8];
        const float keep = b0 ? part[j + 8] : part[j];
        part[j] = keep + __shfl_xor(send, 1);
      }
#pragma unroll
      for (int j = 0; j < 4; ++j) {
        const float send = b1 ? part[j] : part[j + 4];
        const float keep = b1 ? part[j + 4] : part[j];
        part[j] = keep + __shfl_xor(send, 2);
      }
#pragma unroll
      for (int j = 0; j < 2; ++j) {
        const float send = b2 ? part[j] : part[j + 2];
        const float keep = b2 ? part[j + 2] : part[j];
        part[j] = keep + __shfl_xor(send, 4);
      }
      {
        const float send = b3 ? part[0] : part[1];
        const float keep = b3 ? part[1] : part[0];
        part[0] = keep + __shfl_xor(send, 8);
      }
      float a = part[0];
      a += __shfl_xor(a, 16);
      a += __shfl_xor(a, 32);
      a *= suv;
      const float gm = __shfl(gsel, lbase + mypick);
      const float wgt = 0.5f * a * (1.f + erff(a * 0.70710678118654752f)) * gm * svv;
#pragma unroll
      for (int j = 0; j < 16; ++j) {
        const int e = __builtin_amdgcn_readlane(isel, lbase + j);
        const float wj = __uint_as_float((unsigned)__builtin_amdgcn_readlane((int)__float_as_uint(wgt), bitrev4(j)));
        const f32x2 wj2 = {wj, wj};
        const char* vrow = (const char*)p.EV + (size_t)(unsigned)e * EROW;
        const u32x4 w0 = *(const u32x4*)(vrow + loff16);
        const u32x2 w1 = *(const u32x2*)(vrow + loff8);
        v6u_t pk; pk[0] = w0[0]; pk[1] = w0[1]; pk[2] = w0[2]; pk[3] = w0[3]; pk[4] = w1[0]; pk[5] = w1[1];
        const v32f_t v = __builtin_amdgcn_cvt_scalef32_pk32_f32_fp6(pk, 1.0f);
#pragma unroll
        for (int q = 0; q < 16; ++q) { f32x2 t = {v[2 * q], v[2 * q + 1]}; out[q] = wj2 * t + out[q]; }
        if ((j & 3) == 3) __builtin_amdgcn_sched_barrier(0);
      }
    }
    const float* gate = p.mod + (tok >> 13) * NADA + 5 * DM;
    unsigned ln2 = (unsigned)lane;
    asm volatile("" : "+v"(ln2));
    float* orow = p.out + (size_t)tok * DM;
#pragma unroll
    for (int j = 0; j < 8; ++j) {
      const unsigned col = (unsigned)(j * 256) + ln2 * 4u;
      const u32x2 xw = *(const u32x2*)(p.x1b + (size_t)tok * DM + col);
      f32x4 xv; xv[0] = bf_lo(xw[0]); xv[1] = bf_hi(xw[0]); xv[2] = bf_lo(xw[1]); xv[3] = bf_hi(xw[1]);
      const f32x4 gt = *(const f32x4*)(gate + col);
      f32x4 o;
      o[0] = xv[0] + gt[0] * out[2 * j].x;
      o[1] = xv[1] + gt[1] * out[2 * j].y;
      o[2] = xv[2] + gt[2] * out[2 * j + 1].x;
      o[3] = xv[3] + gt[3] * out[2 * j + 1].y;
      *(f32x4*)(orow + col) = o;
    }
  }
}


DI void grid_barrier(unsigned* ctrl, unsigned k) {
  __syncthreads();
  if (my_tid() == 0) {
    __threadfence();
    unsigned bid = blockIdx.x, G = gridDim.x;
    asm volatile("" : "+s"(bid), "+s"(G));
    const unsigned g = bid & 7;
    const unsigned nbg = (G - g + 7) >> 3;
    const unsigned prev = __hip_atomic_fetch_add(&ctrl[64 + g * 64], 1u, __ATOMIC_RELAXED, __HIP_MEMORY_SCOPE_AGENT);
    if (prev + 1 == nbg * (k + 1)) {
      const unsigned p2 = __hip_atomic_fetch_add(&ctrl[640], 1u, __ATOMIC_RELAXED, __HIP_MEMORY_SCOPE_AGENT);
      if (p2 + 1 == 8u * (k + 1)) __hip_atomic_store(&ctrl[704], k + 1, __ATOMIC_RELAXED, __HIP_MEMORY_SCOPE_AGENT);
    }
    while (__hip_atomic_load(&ctrl[704], __ATOMIC_RELAXED, __HIP_MEMORY_SCOPE_AGENT) < k + 1) __builtin_amdgcn_s_sleep(2);
    __threadfence();
  }
  __syncthreads();
}

typedef const Params __attribute__((address_space(4)))* KParams;
#define FRESH_PARAMS(q) asm volatile("" : "+s"(kp)); Params q; __builtin_memcpy(&q, kp, sizeof(Params));

__global__ void __launch_bounds__(NTHREADS, 2) fwd_megakernel(Params p_unused) {
  cg::grid_group grid = cg::this_grid();
  extern __shared__ __attribute__((aligned(16))) char lds[];
  __shared__ int s_item;
  __shared__ float s_lam;
  const int tid = my_tid();
  const int G = gridDim.x;
  KParams kp = (KParams)__builtin_amdgcn_kernarg_segment_ptr();
  if (gridDim.y == 0x7fffu) grid.sync();
  {
    FRESH_PARAMS(p)
    for (int it = blockIdx.x; it < NADA / 48; it += G) ada_item(p, it, (float*)lds);
    wqk_phase(p);
    for (int it = blockIdx.x; it < (DM / 64) * (INC / 64) / 2; it += G) transpose_item(p.w_in, p.WinT, DM, INC, it, (float*)lds);
    for (int it = blockIdx.x; it < (DM / 64) * (DM / 64) / 2; it += G) transpose_item(p.w_out, p.WoutT, DM, DM, it, (float*)lds);
    for (int i = blockIdx.x * NTHREADS + tid; i < NT * 32; i += G * NTHREADS) {
      const int t = i >> 5, f = i & 31;
      const float inv_freq = powf(10000.f, -(float)(2 * f) / 64.f);
      const float ang = (float)p.pos[t] * inv_freq;
      float s, c;
      sincosf(ang, &s, &c);
      p.ropec[i] = c; p.ropes[i] = s;
    }
  }
  { FRESH_PARAMS(pb) grid_barrier(pb.ctrl, 0u); }
  { FRESH_PARAMS(p) norm_mod_phase<false>(p.x, p.g1, p.mod, 0, p.hbuf); }
  { FRESH_PARAMS(pb) grid_barrier(pb.ctrl, 1u); }
  { FRESH_PARAMS(p) gemm_phase<1>(p, p.hbuf, p.WinT, INC, lds); }
  { FRESH_PARAMS(pb) grid_barrier(pb.ctrl, 2u); }
  { FRESH_PARAMS(p) attn_phase(p, lds, &s_item, &s_lam); }
  { FRESH_PARAMS(pb) grid_barrier(pb.ctrl, 3u); }
  { FRESH_PARAMS(p) gemm_phase<2>(p, p.mixA, p.WoutT, DM, lds); }
  { FRESH_PARAMS(pb) grid_barrier(pb.ctrl, 4u); }
  { FRESH_PARAMS(p) norm_mod_phase<true>(p.x1b, p.g2, p.mod, 3, p.hbuf); }
  { FRESH_PARAMS(pb) grid_barrier(pb.ctrl, 5u); }
  { FRESH_PARAMS(p) gemm_phase<3>(p, p.hbuf, p.WqkT, DM, lds); }
  { FRESH_PARAMS(pb) grid_barrier(pb.ctrl, 6u); }
  { FRESH_PARAMS(p) expert_phase(p); }
}

extern "C" void kernel_launch(void* const* d_in, const int* in_sizes, int n_in, void* d_out, int out_size, void* d_ws,
                              size_t ws_size, hipStream_t stream) {
  static int grid_blocks = 0;
  if (!grid_blocks) {
    int dev = 0, cus = 0, per_cu = 0;
    (void)hipGetDevice(&dev);
    (void)hipDeviceGetAttribute(&cus, hipDeviceAttributeMultiprocessorCount, dev);
    (void)hipFuncSetAttribute((const void*)fwd_megakernel, hipFuncAttributeMaxDynamicSharedMemorySize, LDS_BYTES);
    (void)hipOccupancyMaxActiveBlocksPerMultiprocessor(&per_cu, fwd_megakernel, NTHREADS, LDS_BYTES);
    per_cu = 1;
    grid_blocks = cus * per_cu;
  }
  Params p{};
  p.x = (const float*)d_in[0]; p.c = (const float*)d_in[1]; p.pos = (const int*)d_in[2]; p.w_ada = (const float*)d_in[3];
  p.b_ada = (const float*)d_in[4]; p.g1 = (const float*)d_in[5]; p.w_in = (const float*)d_in[6]; p.conv_w = (const float*)d_in[7];
  p.qg = (const float*)d_in[8]; p.kg = (const float*)d_in[9]; p.lq1 = (const float*)d_in[10]; p.lk1 = (const float*)d_in[11];
  p.lq2 = (const float*)d_in[12]; p.lk2 = (const float*)d_in[13]; p.subg = (const float*)d_in[14]; p.w_out = (const float*)d_in[15];
  p.g2 = (const float*)d_in[16]; p.w_pq = (const float*)d_in[17]; p.keys1 = (const float*)d_in[18]; p.keys2 = (const float*)d_in[19];
  p.eu = (const float*)d_in[20]; p.ev = (const float*)d_in[21];
  p.out = (float*)d_out;
  char* w = (char*)d_ws;
  size_t off = 0;
  auto take = [&](size_t bytes) { char* r = w + off; off += (bytes + 255) & ~(size_t)255; return r; };
  p.ctrl = (unsigned*)take(4096);
  p.mod = (float*)take((size_t)NB * NADA * 4);
  p.ropec = (float*)take((size_t)NT * 32 * 4);
  p.ropes = (float*)take((size_t)NT * 32 * 4);
  p.WinT = (bf16_t*)take((size_t)INC * DM * 2);
  p.WoutT = (bf16_t*)take((size_t)DM * DM * 2);
  p.WqkT = (bf16_t*)take((size_t)DM * DM * 2);
  p.EU = (unsigned char*)take((size_t)16384 * DM);
  p.EV = (unsigned char*)take((size_t)16384 * DM);
  p.su = (float*)take(16384 * 4);
  p.sv = (float*)take(16384 * 4);
  p.hbuf = (bf16_t*)take((size_t)NT * DM * 2);
  p.mixA = (bf16_t*)take((size_t)NT * DM * 2);
  p.tidx = (int*)take((size_t)NT * 128 * 4);
  p.tg = (float*)take((size_t)NT * 128 * 4);
  char* region = take((size_t)NT * 3072 * 2 + 3 * (size_t)NT * 1024 * 2);
  p.BCH = (bf16_t*)region;
  p.Qb = (bf16_t*)(region + (size_t)NT * 3072 * 2);
  p.Kb = p.Qb + (size_t)NT * 1024;
  p.Vt = p.Kb + (size_t)NT * 1024;
  p.scores = (float*)region;
  p.x1b = p.Kb;
  if (off > ws_size) { fprintf(stderr, "workspace too small: need %zu have %zu\n", off, ws_size); return; }
  if (hipMemsetAsync(p.ctrl, 0, 4096, stream) != hipSuccess) { fprintf(stderr, "memset of the control words failed\n"); return; }
  void* args[] = {&p};
  hipError_t e = hipLaunchCooperativeKernel((void*)fwd_megakernel, dim3(grid_blocks), dim3(NTHREADS), args, LDS_BYTES, stream);
  if (e != hipSuccess) fprintf(stderr, "cooperative launch failed: %s (grid %d)\n", hipGetErrorString(e), grid_blocks);
}
```
